# Optimizing an MI355X kernel written in HIP

```python
import jax, jax.numpy as jnp
from jax import lax
import numpy as np

D_MODEL = 1024
BATCH = 16
SEQ = 2048
DEPTH = 2

D_FF = 2816
FFN_RES_WEIGHT = 0.5
A_WIDTH = D_MODEL // 2
A_CONV_WIDTH = 31
B_WIDTH = D_MODEL // 2
POOL_WINDOWS = (2, 4, 8, 16)
POOL_GROUPS = len(POOL_WINDOWS)
POOL_GROUP_DIM = B_WIDTH // POOL_GROUPS
EVEN_IN_WIDTH = 2 * A_WIDTH + B_WIDTH
C_WIDTH = D_MODEL // 2
SGU_CHUNK = 128
SGU_GROUPS = 4
SGU_GROUP_DIM = C_WIDTH // SGU_GROUPS
D_WIDTH = D_MODEL // 2
SHORTCONV_WIDTH = 3
ODD_IN_WIDTH = 2 * C_WIDTH + 3 * D_WIDTH
MIX_WIDTH = D_MODEL
EPS = 1e-6

kernel_name = "hybrid_conv_pool_sgu_shortconv_macaron"


def rmsnorm(x, g):
    xf = x.astype(jnp.float32)
    y = xf * lax.rsqrt(jnp.mean(xf * xf, axis=-1, keepdims=True) + EPS)
    return (y * g.astype(jnp.float32)).astype(x.dtype)


def layernorm(x, g, b):
    xf = x.astype(jnp.float32)
    mu = jnp.mean(xf, axis=-1, keepdims=True)
    var = jnp.mean(jnp.square(xf - mu), axis=-1, keepdims=True)
    y = (xf - mu) * lax.rsqrt(var + EPS)
    return (y * g.astype(jnp.float32) + b.astype(jnp.float32)).astype(x.dtype)


def swiglu(h, w_gate, w_up, w_down):
    return (jax.nn.silu(h @ w_gate) * (h @ w_up)) @ w_down


def causal_dwconv(x, w):
    k, c = w.shape
    return lax.conv_general_dilated(
        x, w[:, None, :].astype(x.dtype), window_strides=(1,), padding=[(k - 1, 0)],
        dimension_numbers=("NWC", "WIO", "NWC"), feature_group_count=c)


def multiscale_pool(v, pool_w, pool_scale):
    bsz, s, _ = v.shape
    cs = jnp.cumsum(v.astype(jnp.float32), axis=1)
    pos = jnp.arange(1, s + 1)
    means = []
    for gi, win in enumerate(POOL_WINDOWS):
        c = cs[..., gi * POOL_GROUP_DIM:(gi + 1) * POOL_GROUP_DIM]
        shifted = jnp.pad(c[:, :-win], ((0, 0), (win, 0), (0, 0)))
        cnt = jnp.minimum(pos, win).astype(jnp.float32)[:, None]
        means.append((c - shifted) / cnt)
    pooled = jnp.stack(means, axis=2).astype(v.dtype)
    diff = pooled - v.reshape(bsz, s, POOL_GROUPS, POOL_GROUP_DIM)
    out = jnp.einsum("bsgc,gcd->bsgd", diff, pool_w).reshape(bsz, s, B_WIDTH)
    return out * pool_scale


def even_mixer(h, w_in, conv_w, conv_b, ln_g, ln_b, pool_w, pool_scale, w_out):
    z = h @ w_in
    a_val, a_gate, b_in = jnp.split(z, [A_WIDTH, 2 * A_WIDTH], axis=-1)
    a = a_val * jax.nn.sigmoid(a_gate)
    a = causal_dwconv(a, conv_w) + conv_b
    a = jax.nn.silu(layernorm(a, ln_g, ln_b))
    b = multiscale_pool(b_in, pool_w, pool_scale)
    return jnp.concatenate([a, b], axis=-1) @ w_out


def odd_mixer(h, w_in, sgu_ln_g, sgu_ln_b, sgu_w, sgu_b, conv_w, w_out):
    bsz, s, _ = h.shape
    z = h @ w_in
    c_u, c_v, d_b, d_c, d_x = jnp.split(
        z, [C_WIDTH, 2 * C_WIDTH, 2 * C_WIDTH + D_WIDTH, 2 * C_WIDTH + 2 * D_WIDTH], axis=-1)
    c_u = jax.nn.gelu(c_u)
    c_v = layernorm(jax.nn.gelu(c_v), sgu_ln_g, sgu_ln_b)
    mask = jnp.tril(jnp.ones((SGU_CHUNK, SGU_CHUNK), dtype=bool))
    w_s = jnp.where(mask[None], sgu_w, jnp.zeros((), sgu_w.dtype))
    vc = c_v.reshape(bsz, s // SGU_CHUNK, SGU_CHUNK, SGU_GROUPS, SGU_GROUP_DIM)
    mixed = jnp.einsum("gts,bnsgc->bntgc", w_s, vc) + sgu_b.T[:, :, None]
    c_out = c_u * mixed.reshape(bsz, s, C_WIDTH)
    d_out = d_b * causal_dwconv(d_c * d_x, conv_w)
    return jnp.concatenate([c_out, d_out], axis=-1) @ w_out


def setup_inputs(seed: int = 0) -> dict:
    key = jax.random.key(seed)
    ks = iter(jax.random.split(key, 32))
    n_even = (DEPTH + 1) // 2
    n_odd = DEPTH // 2

    def nrm(shape, scale):
        return jax.random.normal(next(ks), shape, jnp.float32) * scale

    def gain(shape):
        return 1.0 + nrm(shape, 0.02)

    return {
        "x": nrm((BATCH, SEQ, D_MODEL), 1.0),
        "ffn1_norm": gain((DEPTH, D_MODEL)),
        "ffn1_w_gate": nrm((DEPTH, D_MODEL, D_FF), D_MODEL ** -0.5),
        "ffn1_w_up": nrm((DEPTH, D_MODEL, D_FF), D_MODEL ** -0.5),
        "ffn1_w_down": nrm((DEPTH, D_FF, D_MODEL), D_FF ** -0.5),
        "mix_norm": gain((DEPTH, D_MODEL)),
        "ffn2_norm": gain((DEPTH, D_MODEL)),
        "ffn2_w_gate": nrm((DEPTH, D_MODEL, D_FF), D_MODEL ** -0.5),
        "ffn2_w_up": nrm((DEPTH, D_MODEL, D_FF), D_MODEL ** -0.5),
        "ffn2_w_down": nrm((DEPTH, D_FF, D_MODEL), D_FF ** -0.5),
        "ev_w_in": nrm((n_even, D_MODEL, EVEN_IN_WIDTH), D_MODEL ** -0.5),
        "ev_conv_w": nrm((n_even, A_CONV_WIDTH, A_WIDTH), A_CONV_WIDTH ** -0.5),
        "ev_conv_b": nrm((n_even, A_WIDTH), 0.02),
        "ev_ln_g": gain((n_even, A_WIDTH)),
        "ev_ln_b": nrm((n_even, A_WIDTH), 0.02),
        "ev_pool_w": nrm((n_even, POOL_GROUPS, POOL_GROUP_DIM, POOL_GROUP_DIM), POOL_GROUP_DIM ** -0.5),
        "ev_pool_scale": 1.0 + nrm((n_even, B_WIDTH), 0.1),
        "ev_w_out": nrm((n_even, MIX_WIDTH, D_MODEL), MIX_WIDTH ** -0.5),
        "od_w_in": nrm((n_odd, D_MODEL, ODD_IN_WIDTH), D_MODEL ** -0.5),
        "od_sgu_ln_g": gain((n_odd, C_WIDTH)),
        "od_sgu_ln_b": nrm((n_odd, C_WIDTH), 0.02),
        "od_sgu_w": nrm((n_odd, SGU_GROUPS, SGU_CHUNK, SGU_CHUNK), SGU_CHUNK ** -0.5),
        "od_sgu_b": 1.0 + nrm((n_odd, SGU_GROUPS, SGU_CHUNK), 0.01),
        "od_conv_w": nrm((n_odd, SHORTCONV_WIDTH, D_WIDTH), SHORTCONV_WIDTH ** -0.5),
        "od_w_out": nrm((n_odd, MIX_WIDTH, D_MODEL), MIX_WIDTH ** -0.5),
        "final_norm": gain((D_MODEL,)),
    }


def reference(x, ffn1_norm, ffn1_w_gate, ffn1_w_up, ffn1_w_down, mix_norm,
              ffn2_norm, ffn2_w_gate, ffn2_w_up, ffn2_w_down,
              ev_w_in, ev_conv_w, ev_conv_b, ev_ln_g, ev_ln_b, ev_pool_w, ev_pool_scale, ev_w_out,
              od_w_in, od_sgu_ln_g, od_sgu_ln_b, od_sgu_w, od_sgu_b, od_conv_w, od_w_out,
              final_norm):
    for i in range(DEPTH):
        x = x + FFN_RES_WEIGHT * swiglu(rmsnorm(x, ffn1_norm[i]), ffn1_w_gate[i], ffn1_w_up[i], ffn1_w_down[i])
        h = rmsnorm(x, mix_norm[i])
        if i % 2 == 0:
            j = i // 2
            y = even_mixer(h, ev_w_in[j], ev_conv_w[j], ev_conv_b[j], ev_ln_g[j], ev_ln_b[j],
                           ev_pool_w[j], ev_pool_scale[j], ev_w_out[j])
        else:
            j = i // 2
            y = odd_mixer(h, od_w_in[j], od_sgu_ln_g[j], od_sgu_ln_b[j], od_sgu_w[j], od_sgu_b[j],
                          od_conv_w[j], od_w_out[j])
        x = x + y
        x = x + FFN_RES_WEIGHT * swiglu(rmsnorm(x, ffn2_norm[i]), ffn2_w_gate[i], ffn2_w_up[i], ffn2_w_down[i])
    return rmsnorm(x, final_norm)
```

```cpp
#include <hip/hip_runtime.h>
#include <hip/hip_cooperative_groups.h>
#include <cstdio>
#include <cstdint>
namespace cg = cooperative_groups;
namespace pg8 {
#define PG8_LAS __attribute__((address_space(3)))
typedef unsigned short bf16_t;
typedef short bf16x8 __attribute__((ext_vector_type(8)));
typedef float f32x4 __attribute__((ext_vector_type(4)));
typedef unsigned u32x4 __attribute__((ext_vector_type(4)));
constexpr int BM = 256, BK = 64, HALF = 128, HTB = HALF * BK * 2  , STAGE_BYTES = 8 * HTB, NXCD = 8, WGM = 8;

__host__ __device__ __forceinline__ int lds_byte(int r, int c) { const int st = (r >> 4) * 2 + (c >> 5), rr = r & 15, cc = c & 31, ob = rr * 64 + cc * 2; return st * 1024 + (ob ^ (((ob >> 9) & 1) << 5)); }
__host__ __device__ __forceinline__ void stage_rc(int b, int& R, int& C) { const int st = b / 1024, sb = b % 1024, swz = sb ^ (((sb >> 9) & 1) << 5); R = (st >> 1) * 16 + swz / 64; C = (st & 1) * 32 + (swz % 64) / 2; }
__host__ __device__ __forceinline__ int perm32(int rho) { const int n = rho >> 4, i = rho & 15; return 8 * (i >> 2) + 4 * n + (i & 3); }

struct Unit { int pm, pn; };
struct Gemm { const bf16_t* A; const bf16_t* Bt; int M, N, K; };

struct StaticOrder {
    int nM, nN, nwg, G, c;
    __host__ __device__ void init(int M, int N, int G_, int c_) { nM = M / BM; nN = N / BM; nwg = nM * nN; G = G_; c = c_; }
    __host__ __device__ bool next(int i, Unit& u) const {
        const long L = (long)i * G + c; if (L >= nwg) return false;
        int wgid = (int)L; { const int q = nwg / NXCD, r = nwg % NXCD, xcd = wgid % NXCD, off = wgid / NXCD; wgid = (xcd < r ? xcd * (q + 1) : r * (q + 1) + (xcd - r) * q) + off; }
        const int nig = WGM * nN, gid = wgid / nig, fm = gid * WGM, gsz = (nM - fm) < WGM ? (nM - fm) : WGM;
        u.pm = fm + ((wgid % nig) % gsz); u.pn = (wgid % nig) / gsz; return true;
    }
    __device__ __forceinline__ void a_ready(const Unit&) const {}
    __device__ __forceinline__ void done(const Unit&) const {}
};
__device__ __forceinline__ unsigned cvt_pk_bf16(float lo, float hi) { unsigned r; asm volatile("v_cvt_pk_bf16_f32 %0, %1, %2" : "=v"(r) : "v"(lo), "v"(hi)); return r; }
typedef float f32x2 __attribute__((ext_vector_type(2)));
constexpr size_t MiB = 1u << 20;
constexpr size_t WS_WGU = 1 * MiB;
constexpr size_t WS_WDN = 45 * MiB;
constexpr size_t WS_WEVIN = 67 * MiB;
constexpr size_t WS_WEVOUT = 70 * MiB;
constexpr size_t WS_WODIN = 72 * MiB;
constexpr size_t WS_WODOUT = 77 * MiB;
constexpr size_t WS_WSGU = 79 * MiB;
constexpr size_t WS_PART = 80 * MiB;
constexpr size_t WS_XB = 82 * MiB;
constexpr size_t WS_H = 146 * MiB;
constexpr size_t WS_Z0 = WS_H, WS_Z1 = WS_H + 32 * MiB, WS_Z2 = WS_H + 64 * MiB, WS_Z3 = WS_H + 96 * MiB;
constexpr size_t WS_AMIX = WS_H + 192 * MiB;
constexpr size_t WS_END = WS_AMIX + 64 * MiB;
constexpr int LDS_BYTES = 147456, LDS_SPARE = 131072;

__device__ __forceinline__ float sigm(float x) { return __builtin_amdgcn_rcpf(1.f + __builtin_amdgcn_exp2f(-1.44269504f * x)); }
__device__ __forceinline__ float gelu_t(float x) { const float u = x * (0.7978845608f + 0.0356774081f * x * x); return x * sigm(2.f * u); }

struct Epi {
    static constexpr bool PERM = true, AFTER_DRAIN = false;
    int ptype;
    unsigned char* ws;
    float alpha; const float* xin; float* xout;
    PG8_LAS unsigned char* lds;
    __device__ __forceinline__ void fused(f32x4 (&)[2][2][4][2], const Unit&, int, int, int, int, PG8_LAS unsigned char*, int, int) const {}
    __device__ __forceinline__ void operator()(const f32x4 (&acc)[2][2][4][2], const Unit& u, int wr, int wc, int fr, int fq, int ui) const {
        const int rowb = u.pm * BM + wr * 64 + fr;
        float* part = (float*)(ws + WS_PART);
        if (ptype == 3) {
            bf16_t* xb = (bf16_t*)(ws + WS_XB);
            const int colb = u.pn * BM + wc * 32 + 8 * fq;
            PG8_LAS float* P = (PG8_LAS float*)(lds + LDS_SPARE);
#pragma unroll
            for (int ai = 0; ai < 2; ++ai)
#pragma unroll
                for (int m = 0; m < 4; ++m) {
                    const size_t off = (size_t)(rowb + ai * HALF + m * 16) * 1024 + colb; float ss = 0.f;
#pragma unroll
                    for (int bj = 0; bj < 2; ++bj) {
                        const u32x4 xo = *(const u32x4*)(xb + off + bj * HALF);
                        const f32x4 x0 = (f32x4){__builtin_bit_cast(float, xo.x << 16), __builtin_bit_cast(float, xo.x & 0xffff0000u), __builtin_bit_cast(float, xo.y << 16), __builtin_bit_cast(float, xo.y & 0xffff0000u)};
                        const f32x4 x1 = (f32x4){__builtin_bit_cast(float, xo.z << 16), __builtin_bit_cast(float, xo.z & 0xffff0000u), __builtin_bit_cast(float, xo.w << 16), __builtin_bit_cast(float, xo.w & 0xffff0000u)};
                        const f32x4 y0 = x0 + alpha * acc[ai][bj][m][0], y1 = x1 + alpha * acc[ai][bj][m][1];
                        u32x4 w; w.x = cvt_pk_bf16(y0[0], y0[1]); w.y = cvt_pk_bf16(y0[2], y0[3]); w.z = cvt_pk_bf16(y1[0], y1[1]); w.w = cvt_pk_bf16(y1[2], y1[3]);
                        *(u32x4*)(xb + off + bj * HALF) = w;
                        ss += (y0[0] * y0[0] + y0[1] * y0[1]) + (y0[2] * y0[2] + y0[3] * y0[3]) + (y1[0] * y1[0] + y1[1] * y1[1]) + (y1[2] * y1[2] + y1[3] * y1[3]);
                    }
                    ss += __shfl_xor(ss, 16); ss += __shfl_xor(ss, 32);
                    if (fq == 0) P[(ai * HALF + wr * 64 + m * 16 + fr) * 4 + wc] = ss;
                }
            asm volatile("s_waitcnt lgkmcnt(0)" ::: "memory"); __builtin_amdgcn_s_barrier(); asm volatile("" ::: "memory");
            if (threadIdx.x < 256) { const f32x4 p = *(const PG8_LAS f32x4*)(P + threadIdx.x * 4); part[(size_t)(u.pm * BM + threadIdx.x) * 4 + u.pn] = (p[0] + p[1]) + (p[2] + p[3]); }
            return;
        }
        float rs[2][4];
        { const PG8_LAS float* rst = (const PG8_LAS float*)(lds + LDS_SPARE + 4096) + ui * 256 + wr * 64 + fr;
#pragma unroll
          for (int ai = 0; ai < 2; ++ai)
#pragma unroll
              for (int m = 0; m < 4; ++m) rs[ai][m] = rst[ai * HALF + m * 16]; }
        int kind, act, ld, col0; size_t obase;
        const int pn = u.pn;
        if (ptype == 0) { kind = 0; act = 0; obase = WS_H; ld = 2816; col0 = 128 * pn; }
        else if (ptype == 1) { ld = 512; if (pn < 4) { kind = 0; act = 1; obase = WS_Z0; col0 = 128 * pn; } else { kind = 1; act = 0; obase = WS_Z1; col0 = 256 * (pn - 4); } }
        else { ld = 512;
            if (pn < 2) { kind = 1; act = 1; obase = WS_Z0; col0 = 256 * pn; } else if (pn < 4) { kind = 1; act = 1; obase = WS_Z1; col0 = 256 * (pn - 2); }
            else if (pn < 6) { kind = 1; act = 0; obase = WS_Z2; col0 = 256 * (pn - 4); } else { kind = 0; act = 2; obase = WS_Z3; col0 = 128 * (pn - 6); } }
        bf16_t* out = (bf16_t*)(ws + obase) + col0 + wc * 32 + 8 * fq;
        if (kind == 0) {
#pragma unroll
            for (int ai = 0; ai < 2; ++ai)
#pragma unroll
                for (int m = 0; m < 4; ++m) { const float r = rs[ai][m]; bf16_t* rowp = out + (size_t)(rowb + ai * HALF + m * 16) * ld;
                    float o[8];
#pragma unroll
                    for (int n = 0; n < 2; ++n)
#pragma unroll
                        for (int i = 0; i < 4; ++i) { const float a = acc[ai][0][m][n][i] * r, b = acc[ai][1][m][n][i] * r;
                            o[n * 4 + i] = (act == 0) ? a * sigm(a) * b : ((act == 1) ? a * sigm(b) : a * b); }
                    u32x4 w; w.x = cvt_pk_bf16(o[0], o[1]); w.y = cvt_pk_bf16(o[2], o[3]); w.z = cvt_pk_bf16(o[4], o[5]); w.w = cvt_pk_bf16(o[6], o[7]);
                    *(u32x4*)rowp = w; }
        } else {
#pragma unroll
            for (int ai = 0; ai < 2; ++ai)
#pragma unroll
                for (int m = 0; m < 4; ++m) { const float r = rs[ai][m]; bf16_t* rowp = out + (size_t)(rowb + ai * HALF + m * 16) * ld;
#pragma unroll
                    for (int bj = 0; bj < 2; ++bj) { float o[8];
#pragma unroll
                        for (int n = 0; n < 2; ++n)
#pragma unroll
                            for (int i = 0; i < 4; ++i) { const float a = acc[ai][bj][m][n][i] * r; o[n * 4 + i] = act ? gelu_t(a) : a; }
                        u32x4 w; w.x = cvt_pk_bf16(o[0], o[1]); w.y = cvt_pk_bf16(o[2], o[3]); w.z = cvt_pk_bf16(o[4], o[5]); w.w = cvt_pk_bf16(o[6], o[7]);
                        *(u32x4*)(rowp + bj * HALF) = w; } }
        }
    }
};

template <class Epi, class Sched, bool ALIGN_EPI = false, bool SP2 = false>
__device__ __forceinline__ void gemm_phase(PG8_LAS unsigned char* lds, const Gemm g, const Sched& S, const Epi& E) {
    int tid_ = threadIdx.x; asm volatile("" : "+v"(tid_));
    const int tid = tid_, wid = __builtin_amdgcn_readfirstlane(tid >> 6), lane = tid & 63, wr = wid >> 2, wc = wid & 3, fr = lane & 15, fq = lane >> 4;
    const int K = g.K, nt = K / BK;
    const int sr = lane >> 3, sq = (lane & 7) ^ (sr & 6), sR = 8 * wid + sr;
    const int sRb = Epi::PERM ? ((sR & ~31) + perm32(sR & 31)) : sR;
    const unsigned voffA = (unsigned)(sR * K + sq * 8) * 2u, voffB = (unsigned)(sRb * K + sq * 8) * 2u;
    const unsigned h64 = 64u * (unsigned)K * 2u;
    const unsigned kstep = (unsigned)(BK * 2);
    const unsigned hstep = (unsigned)HALF * (unsigned)K * 2u;
    const unsigned tstep = 2u * hstep;
    const unsigned ldsw = (unsigned)wid * 1024u;
    int aoff0, boff0;
    { const int Ra = wr * 64 + fr, Rb_ = wc * 32 + fr;
      aoff0 = (Ra >> 3) * 1024 + ((Ra & 7) * 8 + (fq ^ (Ra & 6))) * 16; boff0 = (Rb_ >> 3) * 1024 + ((Rb_ & 7) * 8 + (fq ^ (Rb_ & 6))) * 16; }
#define PG8_SA(b, h) (((b) * 2 + (h)) * HTB)
#define PG8_SB(b, h) ((4 + (b) * 2 + (h)) * HTB)
    const __amdgpu_buffer_rsrc_t rsA = __builtin_amdgcn_make_buffer_rsrc((void*)g.A, (short)0, (int)((unsigned)g.M * (unsigned)K * 2u), 0x00020000);
    const __amdgpu_buffer_rsrc_t rsB = __builtin_amdgcn_make_buffer_rsrc((void*)g.Bt, (short)0, (int)((unsigned)g.N * (unsigned)K * 2u), 0x00020000);
#define PG8_STAGE_R(bufoff, rs, goff, voff) do { _Pragma("unroll") for (int _i = 0; _i < 2; ++_i) \
        __builtin_amdgcn_raw_ptr_buffer_load_lds(rs, (PG8_LAS void*)(lds + (bufoff) + ldsw + _i * 8192), 16, (voff), (goff) + _i * h64, 0, 0); } while (0)
#define PG8_LDA(dst, b, h) do { int _a1 = aoff0; asm volatile("" : "+v"(_a1)); _a1 ^= 64; _Pragma("unroll") for (int m = 0; m < 4; ++m) { dst[m][0] = *(const PG8_LAS bf16x8*)(lds + PG8_SA(b, h) + aoff0 + m * 2048); dst[m][1] = *(const PG8_LAS bf16x8*)(lds + PG8_SA(b, h) + _a1 + m * 2048); } } while (0)
#define PG8_LDB(dst, b, h) do { int _b1 = boff0; asm volatile("" : "+v"(_b1)); _b1 ^= 64; _Pragma("unroll") for (int n = 0; n < 2; ++n) { dst[n][0] = *(const PG8_LAS bf16x8*)(lds + PG8_SB(b, h) + boff0 + n * 2048); dst[n][1] = *(const PG8_LAS bf16x8*)(lds + PG8_SB(b, h) + _b1 + n * 2048); } } while (0)
#define PG8_MMA(ai, bj, At, Bt) do { __builtin_amdgcn_s_setprio(1); _Pragma("unroll") for (int m = 0; m < 4; ++m) _Pragma("unroll") for (int n = 0; n < 2; ++n) _Pragma("unroll") for (int k = 0; k < 2; ++k) \
        acc[ai][bj][m][n] = __builtin_amdgcn_mfma_f32_16x16x32_bf16(Bt[n][k], At[m][k], acc[ai][bj][m][n], 0, 0, 0); __builtin_amdgcn_s_setprio(0); } while (0)
#define PG8_WAIT_V(n) asm volatile("s_waitcnt vmcnt(" #n ")" ::: "memory")
#define PG8_WAIT_L(n) asm volatile("s_waitcnt lgkmcnt(" #n ")" ::: "memory")
#define PG8_BAR __builtin_amdgcn_s_barrier()
#define PG8_SCHED __builtin_amdgcn_sched_barrier(0)
    Unit cur, nxt; int ui = 0;
    if (!S.next(0, cur)) return;
    f32x4 acc[2][2][4][2];
#pragma unroll
    for (int a = 0; a < 2; ++a)
#pragma unroll
        for (int b = 0; b < 2; ++b)
#pragma unroll
            for (int m = 0; m < 4; ++m)
#pragma unroll
                for (int n = 0; n < 2; ++n) acc[a][b][m][n] = (f32x4){0.f, 0.f, 0.f, 0.f};
    bf16x8 At[4][2], B0[2][2], B1[2][2];
    unsigned cA = (unsigned)cur.pm * tstep, cB = (unsigned)cur.pn * tstep;
    S.a_ready(cur);
    if constexpr (SP2) {
        PG8_STAGE_R(PG8_SB(0, 0), rsB, cB, voffB); PG8_STAGE_R(PG8_SB(0, 1), rsB, cB + hstep, voffB); PG8_STAGE_R(PG8_SA(0, 0), rsA, cA, voffA); PG8_STAGE_R(PG8_SA(0, 1), rsA, cA + hstep, voffA);
        if (wr == 1) PG8_BAR;
        PG8_WAIT_V(2); PG8_BAR;
        PG8_STAGE_R(PG8_SB(1, 0), rsB, cB + kstep, voffB); PG8_STAGE_R(PG8_SA(1, 0), rsA, cA + kstep, voffA); PG8_STAGE_R(PG8_SB(1, 1), rsB, cB + hstep + kstep, voffB);
        PG8_WAIT_V(6); PG8_BAR;
    } else {
        PG8_STAGE_R(PG8_SB(0, 0), rsB, cB, voffB); PG8_STAGE_R(PG8_SA(0, 0), rsA, cA, voffA); PG8_STAGE_R(PG8_SB(0, 1), rsB, cB + hstep, voffB); PG8_STAGE_R(PG8_SA(0, 1), rsA, cA + hstep, voffA);
        if (wr == 1) PG8_BAR;
        PG8_WAIT_V(4); PG8_BAR;
        PG8_STAGE_R(PG8_SB(1, 0), rsB, cB + kstep, voffB); PG8_STAGE_R(PG8_SA(1, 0), rsA, cA + kstep, voffA); PG8_STAGE_R(PG8_SB(1, 1), rsB, cB + hstep + kstep, voffB);
        PG8_WAIT_V(6); PG8_BAR;
    }
    for (;;) {
        const bool has_next = S.next(ui + 1, nxt);
        const unsigned nA = has_next ? (unsigned)nxt.pm * tstep : cA, nB = has_next ? (unsigned)nxt.pn * tstep : cB;
        for (int t = 0; t < nt; t += 2) {
            const bool last = (t == nt - 2);
            const unsigned a1 = cA + (unsigned)(t + 1) * kstep;
            const unsigned a2 = last ? nA : cA + (unsigned)(t + 2) * kstep, b2 = last ? nB : cB + (unsigned)(t + 2) * kstep;
            const unsigned a3 = a2 + kstep, b3 = b2 + kstep;
            if (last && has_next) S.a_ready(nxt);
            if constexpr (SP2) {
            PG8_LDB(B0, 0, 0); PG8_LDB(B1, 0, 1); PG8_SCHED; PG8_LDA(At, 0, 0); PG8_STAGE_R(PG8_SA(1, 1), rsA, a1 + hstep, voffA);
            PG8_WAIT_V(8); PG8_WAIT_L(0); PG8_BAR; PG8_MMA(0, 0, At, B0); PG8_MMA(0, 1, At, B1); PG8_BAR; PG8_SCHED;
            PG8_LDA(At, 0, 1); PG8_STAGE_R(PG8_SB(0, 0), rsB, b2, voffB); PG8_STAGE_R(PG8_SB(0, 1), rsB, b2 + hstep, voffB); PG8_STAGE_R(PG8_SA(0, 0), rsA, a2, voffA);
            PG8_WAIT_V(8); PG8_WAIT_L(0); PG8_BAR; PG8_MMA(1, 0, At, B0); PG8_MMA(1, 1, At, B1); PG8_BAR; PG8_SCHED;
            PG8_LDB(B0, 1, 0); PG8_LDB(B1, 1, 1); PG8_SCHED; PG8_LDA(At, 1, 0); PG8_STAGE_R(PG8_SA(0, 1), rsA, a2 + hstep, voffA);
            PG8_WAIT_V(8); PG8_WAIT_L(0); PG8_BAR; PG8_MMA(0, 0, At, B0); PG8_MMA(0, 1, At, B1); PG8_BAR; PG8_SCHED;
            PG8_LDA(At, 1, 1); PG8_STAGE_R(PG8_SB(1, 0), rsB, b3, voffB); PG8_STAGE_R(PG8_SB(1, 1), rsB, b3 + hstep, voffB); PG8_STAGE_R(PG8_SA(1, 0), rsA, a3, voffA);
            PG8_WAIT_V(8); PG8_WAIT_L(0); PG8_BAR; PG8_MMA(1, 0, At, B0); PG8_MMA(1, 1, At, B1); PG8_BAR; PG8_SCHED;
            } else {
            PG8_LDB(B0, 0, 0); PG8_SCHED; PG8_LDA(At, 0, 0); PG8_STAGE_R(PG8_SA(1, 1), rsA, a1 + hstep, voffA);
            PG8_WAIT_L(8); PG8_BAR; PG8_WAIT_L(0); PG8_MMA(0, 0, At, B0); PG8_BAR; PG8_SCHED;
            PG8_LDB(B1, 0, 1); PG8_STAGE_R(PG8_SB(0, 0), rsB, b2, voffB);
            PG8_BAR; PG8_WAIT_L(0); PG8_MMA(0, 1, At, B1); PG8_BAR;
            PG8_LDA(At, 0, 1); PG8_STAGE_R(PG8_SA(0, 0), rsA, a2, voffA);
            PG8_BAR; PG8_WAIT_L(0); PG8_MMA(1, 0, At, B0); PG8_BAR; PG8_SCHED;
            PG8_STAGE_R(PG8_SB(0, 1), rsB, b2 + hstep, voffB);
            PG8_WAIT_V(6); PG8_BAR; PG8_MMA(1, 1, At, B1); PG8_BAR;
            PG8_LDB(B0, 1, 0); PG8_SCHED; PG8_LDA(At, 1, 0); PG8_STAGE_R(PG8_SA(0, 1), rsA, a2 + hstep, voffA);
            PG8_WAIT_L(8); PG8_BAR; PG8_WAIT_L(0); PG8_MMA(0, 0, At, B0); PG8_BAR; PG8_SCHED;
            PG8_LDB(B1, 1, 1); PG8_STAGE_R(PG8_SB(1, 0), rsB, b3, voffB);
            PG8_BAR; PG8_WAIT_L(0); PG8_MMA(0, 1, At, B1); PG8_BAR;
            PG8_LDA(At, 1, 1); PG8_STAGE_R(PG8_SA(1, 0), rsA, a3, voffA);
            PG8_BAR; PG8_WAIT_L(0); PG8_MMA(1, 0, At, B0); PG8_BAR; PG8_SCHED;
            PG8_STAGE_R(PG8_SB(1, 1), rsB, b3 + hstep, voffB);
            PG8_WAIT_V(6); PG8_BAR; PG8_MMA(1, 1, At, B1); PG8_BAR;
            }
        }
        if constexpr (ALIGN_EPI) { if (wr == 0) PG8_BAR; }
        if constexpr (!Epi::AFTER_DRAIN) { E(acc, cur, wr, wc, fr, fq, ui); S.done(cur); }
        if (!has_next) break;
#pragma unroll
        for (int a = 0; a < 2; ++a)
#pragma unroll
            for (int b = 0; b < 2; ++b)
#pragma unroll
                for (int m = 0; m < 4; ++m)
#pragma unroll
                    for (int n = 0; n < 2; ++n) acc[a][b][m][n] = (f32x4){0.f, 0.f, 0.f, 0.f};
        cur = nxt; cA = nA; cB = nB; ++ui;
        if constexpr (ALIGN_EPI) { if (wr == 1) PG8_BAR; }
    }
    PG8_WAIT_V(0);
    if constexpr (!ALIGN_EPI) { if (wr == 0) PG8_BAR; }
    PG8_BAR;
    if constexpr (Epi::AFTER_DRAIN) { E.fused(acc, cur, wr, wc, fr, fq, lds, wid, lane); S.done(cur); }
#undef PG8_SA
#undef PG8_SB
#undef PG8_STAGE_R
#undef PG8_LDA
#undef PG8_LDB
#undef PG8_MMA
#undef PG8_WAIT_V
#undef PG8_WAIT_L
#undef PG8_BAR
#undef PG8_SCHED
}
}
#define LAS __attribute__((address_space(3)))
typedef unsigned short bf16;
typedef float f32x4 __attribute__((ext_vector_type(4)));
typedef float f32x2 __attribute__((ext_vector_type(2)));
typedef unsigned u32x4 __attribute__((ext_vector_type(4)));
typedef unsigned u32x2 __attribute__((ext_vector_type(2)));
typedef short bf16x8 __attribute__((ext_vector_type(8)));
using pg8::WS_WGU; using pg8::WS_WDN; using pg8::WS_WEVIN; using pg8::WS_WEVOUT; using pg8::WS_WODIN; using pg8::WS_WODOUT; using pg8::WS_WSGU; using pg8::WS_PART; using pg8::WS_XB;
using pg8::WS_H; using pg8::WS_Z0; using pg8::WS_Z1; using pg8::WS_Z2; using pg8::WS_Z3; using pg8::WS_AMIX; using pg8::WS_END; using pg8::LDS_BYTES; using pg8::MiB; using pg8::sigm;

constexpr int M = 32768, D = 1024, FF = 2816, SEQ = 2048;
constexpr int NWAVES = 8;
#define LDS_WAIT() asm volatile("s_waitcnt lgkmcnt(0)" ::: "memory")

__device__ __forceinline__ unsigned f2bf(float f) { unsigned u = __builtin_bit_cast(unsigned, f); return (u + 0x7fffu + ((u >> 16) & 1u)) >> 16; }
__device__ __forceinline__ unsigned pk2(float lo, float hi) { return f2bf(lo) | (f2bf(hi) << 16); }
__device__ __forceinline__ float bf_lo(unsigned u) { return __builtin_bit_cast(float, u << 16); }
__device__ __forceinline__ float bf_hi(unsigned u) { return __builtin_bit_cast(float, u & 0xffff0000u); }
__device__ __forceinline__ float wave_sum(float v) {
#pragma unroll
    for (int o = 1; o < 64; o <<= 1) v += __shfl_xor(v, o);
    return v;
}

template <class T> __device__ __forceinline__ T* launder(T* p) { asm volatile("" : "+s"(p)); return p; }
__device__ __forceinline__ int dest_row(int wkind, int n0) {
    if (wkind == 0) return n0;
    if (wkind == 1) return 256 * (n0 >> 7) + (n0 & 127);
    if (wkind == 2) return 256 * (n0 >> 7) + 128 + (n0 & 127);
    if (wkind == 3) { if (n0 < 512) return 256 * (n0 >> 7) + (n0 & 127); if (n0 < 1024) { const int q = n0 - 512; return 256 * (q >> 7) + 128 + (q & 127); } return n0; }
    if (n0 < 1536) return n0;
    if (n0 < 2048) { const int q = n0 - 1536; return 1536 + 256 * (q >> 7) + (q & 127); }
    { const int q = n0 - 2048; return 1536 + 256 * (q >> 7) + 128 + (q & 127); }
}
__device__ __forceinline__ void transpose_item(const float* W, int N, bf16* WT, int kpitch, const float* gain, int wkind, LAS float* scr, int item, int lane) {
    const int nblk = N / 32, kb = item / nblk, nb = item % nblk, k0 = 64 * kb, n0 = 32 * nb;
    float tv[32];
#pragma unroll
    for (int i = 0; i < 32; ++i) tv[i] = W[(size_t)(k0 + 2 * i + (lane >> 5)) * N + n0 + (lane & 31)];
    if (gain) {
#pragma unroll
        for (int i = 0; i < 32; ++i) tv[i] *= gain[k0 + 2 * i + (lane >> 5)]; }
#pragma unroll
    for (int i = 0; i < 32; ++i) scr[(2 * i + (lane >> 5)) * 33 + (lane & 31)] = tv[i];
    LDS_WAIT(); asm volatile("" ::: "memory");
    const int c = lane & 7, drow = dest_row(wkind, n0);
#pragma unroll
    for (int j = 0; j < 4; ++j) { const int n = (lane >> 3) + 8 * j; const LAS float* s = scr + (8 * c) * 33 + n;
        u32x4 o; o.x = pk2(s[0 * 33], s[1 * 33]); o.y = pk2(s[2 * 33], s[3 * 33]); o.z = pk2(s[4 * 33], s[5 * 33]); o.w = pk2(s[6 * 33], s[7 * 33]);
        *(u32x4*)(WT + (size_t)(drow + n) * kpitch + k0 + 8 * c) = o; }
    LDS_WAIT(); asm volatile("" ::: "memory");
}

#define XB_TMO      128
#define XB_XCNT(j)  (256  + 64 * (j))
#define XB_XSUB(j)  (1280 + 64 * (j))
#define XB_XGEN(j)  (2304 + 64 * (j))
#define XB_TOP      3328
#define XB_TOPGEN   3392
#define XCD_BAR_WORDS 3456
#define XB_SPIN_CAP (1u << 18)

__device__ __forceinline__ unsigned xb_ld(unsigned* p)              { return __hip_atomic_load(p, __ATOMIC_RELAXED, __HIP_MEMORY_SCOPE_AGENT); }
__device__ __forceinline__ unsigned xb_add(unsigned* p, unsigned v) { return __hip_atomic_fetch_add(p, v, __ATOMIC_RELAXED, __HIP_MEMORY_SCOPE_AGENT); }
__device__ __forceinline__ unsigned xb_xcc_id() { return (unsigned)__builtin_amdgcn_s_getreg((3 << 11) | 20) & 0xFu; }
#define XB_SPIN(cond, bar) do { unsigned _sp = 0; while (cond) { __builtin_amdgcn_s_sleep(1); \
    if ((++_sp & 255u) == 0u) { if (xb_ld(&(bar)[XB_TMO])) break; if (_sp > XB_SPIN_CAP) { atomicAdd(&(bar)[XB_TMO], 1u); break; } } } } while (0)

struct XcdBarrier {
    unsigned* bar; unsigned x;
    volatile LAS unsigned* st;
};

__device__ __forceinline__ XcdBarrier xcd_barrier_post(unsigned* bar, volatile LAS unsigned* st) {
    XcdBarrier b; b.bar = bar; b.x = xb_xcc_id(); b.st = st;
    if (threadIdx.x == 0) (void)xb_add(&bar[XB_XCNT(b.x)], 1u);
    return b;
}
__device__ __forceinline__ void xcd_barrier_complete(unsigned* bar, unsigned x, unsigned& nloc, unsigned& nx) {
    const unsigned G = gridDim.x * gridDim.y * gridDim.z;
    unsigned sum, cnt, mine, sp = 0u;
    for (;;) {
        sum = 0u; cnt = 0u; mine = 0u;
#pragma unroll
        for (unsigned j = 0; j < 16; ++j) { const unsigned c = xb_ld(&bar[XB_XCNT(j)]); sum += c; cnt += (c > 0u) ? 1u : 0u; mine = (j == x) ? c : mine; }
        if (sum == G) break;
        __builtin_amdgcn_s_sleep(1);
        if ((++sp & 255u) == 0u) { if (xb_ld(&bar[XB_TMO])) break; if (sp > XB_SPIN_CAP) { atomicAdd(&bar[XB_TMO], 1u); break; } }
    }
    nloc = mine > 0u ? mine : 1u; nx = cnt > 0u ? cnt : 1u;
}

__device__ __forceinline__ void xcd_barrier(const XcdBarrier& b) {
    asm volatile("s_waitcnt vmcnt(0)" ::: "memory");
    __syncthreads();
    if (threadIdx.x == 0) {
        unsigned* bar = b.bar;
        __builtin_amdgcn_s_waitcnt(0);
        unsigned nloc = b.st[0], nx = b.st[1];
        if (nloc == 0u) { xcd_barrier_complete(bar, b.x, nloc, nx); b.st[0] = nloc; b.st[1] = nx; }
        const unsigned old = xb_add(&bar[XB_XSUB(b.x)], 1u);
        const unsigned gen = old / nloc;
        if (old + 1u == (gen + 1u) * nloc) {
            __builtin_amdgcn_fence(__ATOMIC_RELEASE, "agent");
            asm volatile("s_waitcnt vmcnt(0)" ::: "memory");
            const unsigned og = xb_add(&bar[XB_TOP], 1u);
            const unsigned tg = og / nx;
            if (og + 1u == (tg + 1u) * nx) xb_add(&bar[XB_TOPGEN], 1u);
            else XB_SPIN(xb_ld(&bar[XB_TOPGEN]) == tg, bar);
            __builtin_amdgcn_fence(__ATOMIC_ACQUIRE, "agent");
            xb_add(&bar[XB_XGEN(b.x)], 1u);
            asm volatile("s_waitcnt vmcnt(0)" ::: "memory");
        } else {
            XB_SPIN(xb_ld(&bar[XB_XGEN(b.x)]) == gen, bar);
            __builtin_amdgcn_fence(__ATOMIC_ACQUIRE, "agent");
            asm volatile("s_waitcnt vmcnt(0)" ::: "memory");
        }
    }
    __syncthreads();
}

struct Args { const float* in[26]; float* out; unsigned char* ws; };
enum { I_X = 0, I_F1N, I_F1G, I_F1U, I_F1D, I_MIXN, I_F2N, I_F2G, I_F2U, I_F2D, I_EVIN, I_EVCW, I_EVCB, I_EVLG, I_EVLB, I_EVPW, I_EVPS, I_EVOUT, I_ODIN, I_ODLG, I_ODLB, I_ODSW, I_ODSB, I_ODCW, I_ODOUT, I_FINAL };

typedef const __attribute__((address_space(4))) Args* KArgs;
__device__ __forceinline__ KArgs kargs() { KArgs p = (KArgs)__builtin_amdgcn_kernarg_segment_ptr(); asm volatile("" : "+s"(p)); return p; }
__device__ __forceinline__ void prologue(LAS unsigned char* lds) {
    const KArgs ap = kargs();
#define a (*ap)
    const int tid = threadIdx.x, lane = tid & 63, wave = tid >> 6;
    LAS float* scr = (LAS float*)(lds + wave * 16384);
    const int gw = blockIdx.x * NWAVES + wave, NGW = gridDim.x * NWAVES;
    unsigned char* ws = a.ws;
    constexpr int I_FFN = (D / 64) * (FF / 32);
    constexpr int N_FFN = 12 * I_FFN, I_EI = 16 * 48, I_OI = 16 * 80, I_EO = 8 * 32, I_OO = 16 * 32, I_FOLD = 4 * 16 * 16;
    constexpr int NITEMS = N_FFN + I_EI + I_OI + I_EO + I_OO + I_FOLD;
    for (int it = gw; it < NITEMS; it += NGW) {
        int r = it;
        if (r < N_FFN) { const int idx = r / I_FFN, item = r % I_FFN, L = idx / 6, q = idx % 6, f = q / 3, kind = q % 3;
            const float* nrm = a.in[f ? I_F2N : I_F1N] + L * D;
            if (kind == 2) transpose_item(a.in[f ? I_F2D : I_F1D] + (size_t)L * FF * D, D, (bf16*)(ws + WS_WDN) + (size_t)(L * 2 + f) * D * FF, FF, nullptr, 0, scr, item, lane);
            else transpose_item(a.in[kind ? (f ? I_F2U : I_F1U) : (f ? I_F2G : I_F1G)] + (size_t)L * D * FF, FF, (bf16*)(ws + WS_WGU) + (size_t)(L * 2 + f) * 2 * FF * D, D, nrm, 1 + kind, scr, item, lane);
            continue; }
        r -= N_FFN;
        if (r < I_EI) { transpose_item(a.in[I_EVIN], 1536, (bf16*)(ws + WS_WEVIN), D, a.in[I_MIXN], 3, scr, r, lane); continue; } r -= I_EI;
        if (r < I_OI) { transpose_item(a.in[I_ODIN], 2560, (bf16*)(ws + WS_WODIN), D, a.in[I_MIXN] + D, 4, scr, r, lane); continue; } r -= I_OI;
        if (r < I_EO) { transpose_item(a.in[I_EVOUT], D, (bf16*)(ws + WS_WEVOUT), D, nullptr, 0, scr, r, lane); continue; } r -= I_EO;
        if (r < I_OO) { transpose_item(a.in[I_ODOUT], D, (bf16*)(ws + WS_WODOUT), D, nullptr, 0, scr, r, lane); continue; } r -= I_OO;
        {
            const int g = r >> 8, c8 = (r >> 4) & 15, n = ((r & 15) << 6) + lane;
            const float* pw = a.in[I_EVPW] + (size_t)(g * 128 + c8 * 8) * 128; const float* ps = a.in[I_EVPS] + g * 128; const float* wo = a.in[I_EVOUT] + (size_t)(512 + g * 128) * D + n;
            float acc[8];
#pragma unroll
            for (int i = 0; i < 8; ++i) acc[i] = 0.f;
#pragma unroll 4
            for (int d = 0; d < 128; ++d) { const float wv = wo[(size_t)d * D] * ps[d];
#pragma unroll
                for (int i = 0; i < 8; ++i) acc[i] += pw[i * 128 + d] * wv; }
            u32x4 o; o.x = pk2(acc[0], acc[1]); o.y = pk2(acc[2], acc[3]); o.z = pk2(acc[4], acc[5]); o.w = pk2(acc[6], acc[7]);
            *(u32x4*)((bf16*)(ws + WS_WEVOUT) + (size_t)n * D + 512 + g * 128 + c8 * 8) = o;
        }
    }
    { const float* x = a.in[I_X]; bf16* xb = (bf16*)(ws + WS_XB); float* part = (float*)(ws + WS_PART);
      for (int m0 = 2 * gw; m0 < M; m0 += 2 * NGW) { f32x4 v[2][4]; float sq[2];
#pragma unroll
          for (int h = 0; h < 2; ++h) { const f32x4* xr = (const f32x4*)(x + (size_t)(m0 + h) * D) + lane;
#pragma unroll
              for (int j = 0; j < 4; ++j) v[h][j] = xr[64 * j]; }
#pragma unroll
          for (int h = 0; h < 2; ++h) { float s = 0.f;
#pragma unroll
              for (int j = 0; j < 4; ++j) s += (v[h][j][0] * v[h][j][0] + v[h][j][1] * v[h][j][1]) + (v[h][j][2] * v[h][j][2] + v[h][j][3] * v[h][j][3]);
              sq[h] = wave_sum(s);
              u32x2* o8 = (u32x2*)(xb + (size_t)(m0 + h) * D) + lane;
#pragma unroll
              for (int j = 0; j < 4; ++j) { u32x2 w; w.x = pk2(v[h][j][0], v[h][j][1]); w.y = pk2(v[h][j][2], v[h][j][3]); o8[64 * j] = w; }
              if (lane == 0) *(f32x4*)(part + (size_t)(m0 + h) * 4) = (f32x4){sq[h], 0.f, 0.f, 0.f}; } } }
    { const float* sw = a.in[I_ODSW]; bf16* wb = (bf16*)(ws + WS_WSGU);
      for (int i = blockIdx.x * 512 + tid; i < 4 * 128 * 128; i += gridDim.x * 512) { const int t = (i >> 7) & 127, s = i & 127; wb[i] = (bf16)(s <= t ? f2bf(sw[i]) : 0u); } }
}

#undef a
__device__ __forceinline__ void even_local(LAS unsigned char* lds) {
    const KArgs ap = kargs();
#define a (*ap)
    int tid_ = threadIdx.x; asm volatile("" : "+v"(tid_));
    const int tid = tid_, lane = tid & 63, wave = tid >> 6, half = tid >> 8, cp = tid & 255;
    constexpr int TT = 32, NR = TT + 30;
    constexpr int R_W = 67584, R_FIN = 133120, SROW = 264;
    LAS unsigned char* tile = lds; LAS float* stt = (LAS float*)lds; LAS float* wl = (LAS float*)(lds + R_W); LAS float* fin = (LAS float*)(lds + R_FIN);
    const bf16* za = (const bf16*)(a.ws + WS_Z0); const bf16* zb = (const bf16*)(a.ws + WS_Z1); unsigned* amix32 = (unsigned*)(a.ws + WS_AMIX);
    for (int i = tid; i < 32 * 512; i += 512) wl[i] = (i < 31 * 512) ? a.in[I_EVCW][i] : 0.f;
    const f32x2 cb = *(const f32x2*)(a.in[I_EVCB] + 2 * cp), lg = *(const f32x2*)(a.in[I_EVLG] + 2 * cp), lb = *(const f32x2*)(a.in[I_EVLB] + 2 * cp);
    const int win = 2 << (wave & 3);
    u32x4 ra[8], rb[6];
    const int sr0 = tid >> 6, sc16 = tid & 63;
#define EV_LOAD_ZA(T0) do { const int _t0 = (T0), _p0 = _t0 & (SEQ - 1); _Pragma("unroll") for (int q = 0; q < 8; ++q) { const int r = sr0 + 8 * q; ra[q] = (u32x4){0u, 0u, 0u, 0u}; \
        if (_p0 - 30 + r >= 0 && r < NR) ra[q] = *(const u32x4*)(za + (size_t)(_t0 - 30 + r) * 512 + sc16 * 8); } } while (0)
#define EV_LOAD_ZB(T0) do { const int _t0 = (T0), _p0 = _t0 & (SEQ - 1); _Pragma("unroll") for (int q = 0; q < 6; ++q) { const int r = sr0 + 8 * q; rb[q] = (u32x4){0u, 0u, 0u, 0u}; \
        if (_p0 - 15 + r >= 0 && r < 47) rb[q] = *(const u32x4*)(zb + (size_t)(_t0 - 15 + r) * 512 + sc16 * 8); } } while (0)
    if ((int)blockIdx.x < M / TT) EV_LOAD_ZA((int)blockIdx.x * TT);
    for (int it = blockIdx.x; it < M / TT; it += gridDim.x) {
        const int t0 = it * TT, pos0 = t0 & (SEQ - 1);
#pragma unroll
        for (int q = 0; q < 8; ++q) { const int r = sr0 + 8 * q; if (r <= NR) *(LAS u32x4*)(tile + r * 1024 + sc16 * 16) = ra[q]; }
        __syncthreads();
        EV_LOAD_ZB(t0);
        if (it + (int)gridDim.x < M / TT) EV_LOAD_ZA((it + (int)gridDim.x) * TT);
        float a0[16], a1[16];
#pragma unroll
        for (int j = 0; j < 16; ++j) { a0[j] = cb.x; a1[j] = cb.y; }
        { const LAS unsigned char* xb = tile + (half * 16) * 1024 + cp * 4;
#pragma unroll 1
          for (int k4 = 0; k4 < 32; k4 += 4) {
              f32x2 w[4]; float x0[19], x1[19];
#pragma unroll
              for (int q = 0; q < 4; ++q) w[q] = *(const LAS f32x2*)(wl + (k4 + q) * 512 + 2 * cp);
#pragma unroll
              for (int i = 0; i < 19; ++i) { const unsigned u = *(const LAS unsigned*)(xb + (k4 + i) * 1024); x0[i] = bf_lo(u); x1[i] = bf_hi(u); }
#pragma unroll
              for (int q = 0; q < 4; ++q)
#pragma unroll
                  for (int j = 0; j < 16; ++j) { a0[j] += w[q].x * x0[j + q]; a1[j] += w[q].y * x1[j + q]; } } }
        __syncthreads();
#pragma unroll
        for (int j = 0; j < 16; ++j) { const int tok = half * 16 + j, col = (cp >> 5) * 33 + (cp & 31);
            stt[tok * SROW + col] = a0[j] + a1[j]; stt[(32 + tok) * SROW + col] = a0[j] * a0[j] + a1[j] * a1[j]; }
        __syncthreads();
        { const int row = tid >> 3, part = tid & 7; const LAS float* p = stt + row * SROW + part * 33; float sacc = 0.f;
#pragma unroll
          for (int i = 0; i < 32; ++i) sacc += p[i];
          sacc += __shfl_xor(sacc, 1); sacc += __shfl_xor(sacc, 2); sacc += __shfl_xor(sacc, 4);
          if (part == 0) fin[row] = sacc; }
        __syncthreads();
#pragma unroll
        for (int q = 0; q < 6; ++q) { const int r = sr0 + 8 * q; if (r < 47) *(LAS u32x4*)(tile + r * 1024 + sc16 * 16) = rb[q]; }
#pragma unroll
        for (int j = 0; j < 16; ++j) { const int tok = half * 16 + j; const float mean = fin[tok] * (1.f / 512.f), var = fmaxf(fin[32 + tok] * (1.f / 512.f) - mean * mean, 0.f), rstd = __builtin_amdgcn_rsqf(var + 1e-6f);
            const float y0 = (a0[j] - mean) * rstd * lg.x + lb.x, y1 = (a1[j] - mean) * rstd * lg.y + lb.y;
            amix32[(size_t)(t0 + tok) * 512 + cp] = pk2(y0 * sigm(y0), y1 * sigm(y1)); }
        __syncthreads();
        { const LAS unsigned char* xb = tile + (15 + half * 16) * 1024 + cp * 4; const int posb = pos0 + half * 16; float s0 = 0.f, s1 = 0.f;
          for (int i = 1; i < win; ++i) { const unsigned u = *(const LAS unsigned*)(xb - i * 1024); s0 += bf_lo(u); s1 += bf_hi(u); }
#pragma unroll
          for (int j = 0; j < 16; ++j) { const unsigned xt = *(const LAS unsigned*)(xb + j * 1024); const float x0 = bf_lo(xt), x1 = bf_hi(xt); s0 += x0; s1 += x1;
              const int pos = posb + j, n = (pos + 1) < win ? (pos + 1) : win; const float rc = 1.f / (float)n;
              amix32[(size_t)(t0 + half * 16 + j) * 512 + 256 + cp] = pk2(s0 * rc - x0, s1 * rc - x1);
              const unsigned uo = *(const LAS unsigned*)(xb + (j - win + 1) * 1024); s0 -= bf_lo(uo); s1 -= bf_hi(uo); } }
        __syncthreads();
    }
}
#undef EV_LOAD_ZA
#undef EV_LOAD_ZB
#undef a
__device__ __forceinline__ void odd_local(LAS unsigned char* lds) {
    const KArgs ap = kargs();
#define a (*ap)
    constexpr int PITCH = 136;
    int tid_ = threadIdx.x; asm volatile("" : "+v"(tid_));
    const int tid = tid_, lane = tid & 63, wave = __builtin_amdgcn_readfirstlane(tid >> 6), fr = lane & 15, fq = lane >> 4;
    LAS bf16* vcT = (LAS bf16*)lds;
    const bf16* cu = (const bf16*)(a.ws + WS_Z0); const bf16* cv = (const bf16*)(a.ws + WS_Z1); const bf16* db = (const bf16*)(a.ws + WS_Z2); const bf16* dcx = (const bf16*)(a.ws + WS_Z3);
    bf16* amix = (bf16*)(a.ws + WS_AMIX); const bf16* wb = (const bf16*)(a.ws + WS_WSGU);
    float lg[8], lb[8];
#pragma unroll
    for (int j = 0; j < 8; ++j) { lg[j] = a.in[I_ODLG][lane + 64 * j]; lb[j] = a.in[I_ODLB][lane + 64 * j]; }
    for (int chunk = blockIdx.x; chunk < M / 128; chunk += gridDim.x) {
        const int tok0 = chunk * 128;
#pragma unroll 1
        for (int t8 = 0; t8 < 16; t8 += 4) { float v[4][8];
#pragma unroll
            for (int u = 0; u < 4; ++u) { const bf16* row = cv + (size_t)(tok0 + wave * 16 + t8 + u) * 512 + lane;
#pragma unroll
                for (int j = 0; j < 8; ++j) v[u][j] = __builtin_bit_cast(float, (unsigned)row[64 * j] << 16); }
            float mean[4], rstd[4];
#pragma unroll
            for (int u = 0; u < 4; ++u) { float s1 = 0.f, s2 = 0.f;
#pragma unroll
                for (int j = 0; j < 8; ++j) { s1 += v[u][j]; s2 += v[u][j] * v[u][j]; }
                s1 = wave_sum(s1); s2 = wave_sum(s2);
                mean[u] = s1 * (1.f / 512.f); rstd[u] = __builtin_amdgcn_rsqf(fmaxf(s2 * (1.f / 512.f) - mean[u] * mean[u], 0.f) + 1e-6f); }
#pragma unroll
            for (int u = 0; u < 4; u += 2) { const int s = wave * 16 + t8 + u;
#pragma unroll
                for (int j = 0; j < 8; ++j) *(LAS unsigned*)(vcT + (lane + 64 * j) * PITCH + s) = pk2((v[u][j] - mean[u]) * rstd[u] * lg[j] + lb[j], (v[u + 1][j] - mean[u + 1]) * rstd[u + 1] * lg[j] + lb[j]); } }
        __syncthreads();
#pragma unroll 1
        for (int g = 0; g < 4; ++g) {
            bf16x8 xa[4];
#pragma unroll
            for (int ks = 0; ks < 4; ++ks) xa[ks] = *(const LAS bf16x8*)(vcT + (g * 128 + 16 * wave + fr) * PITCH + 32 * ks + 8 * fq);
            const int c = g * 128 + 16 * wave + 4 * fq;
            bf16x8 yb[20]; u32x2 cuv[8]; float bs[8];
            { int idx = 0;
#pragma unroll
              for (int tj = 0; tj < 8; ++tj)
#pragma unroll
                  for (int ks = 0; ks <= tj / 2; ++ks) yb[idx++] = *(const bf16x8*)(wb + (size_t)(g * 128 + 16 * tj + fr) * 128 + 32 * ks + 8 * fq); }
#pragma unroll
            for (int tj = 0; tj < 8; ++tj) { const int t = 16 * tj + fr; cuv[tj] = *(const u32x2*)(cu + (size_t)(tok0 + t) * 512 + c); bs[tj] = a.in[I_ODSB][g * 128 + t]; }
            { int idx = 0;
#pragma unroll
              for (int tj = 0; tj < 8; ++tj) { f32x4 d = (f32x4){0.f, 0.f, 0.f, 0.f};
#pragma unroll
                  for (int ks = 0; ks <= tj / 2; ++ks) d = __builtin_amdgcn_mfma_f32_16x16x32_bf16(xa[ks], yb[idx++], d, 0, 0, 0);
                  const float bias = bs[tj]; const u32x2 uu = cuv[tj];
                  u32x2 o; o.x = pk2(bf_lo(uu.x) * (d[0] + bias), bf_hi(uu.x) * (d[1] + bias)); o.y = pk2(bf_lo(uu.y) * (d[2] + bias), bf_hi(uu.y) * (d[3] + bias));
                  *(u32x2*)(amix + (size_t)(tok0 + 16 * tj + fr) * 1024 + c) = o; } }
        }
        { float cw[3][8];
#pragma unroll
          for (int k = 0; k < 3; ++k) { const f32x4 p = *(const f32x4*)(a.in[I_ODCW] + k * 512 + 8 * lane), q = *(const f32x4*)(a.in[I_ODCW] + k * 512 + 8 * lane + 4);
              cw[k][0] = p[0]; cw[k][1] = p[1]; cw[k][2] = p[2]; cw[k][3] = p[3]; cw[k][4] = q[0]; cw[k][5] = q[1]; cw[k][6] = q[2]; cw[k][7] = q[3]; }
#pragma unroll 1
          for (int t4 = 0; t4 < 16; t4 += 4) { u32x4 bv[4], x0[4], x1[4], x2[4];
#pragma unroll
              for (int u = 0; u < 4; ++u) { const int tok = tok0 + wave * 16 + t4 + u, pos = tok & (SEQ - 1);
                  bv[u] = *(const u32x4*)(db + (size_t)tok * 512 + 8 * lane); x0[u] = *(const u32x4*)(dcx + (size_t)tok * 512 + 8 * lane);
                  x1[u] = *(const u32x4*)(dcx + (size_t)(tok - (pos >= 1 ? 1 : 0)) * 512 + 8 * lane); x2[u] = *(const u32x4*)(dcx + (size_t)(tok - (pos >= 2 ? 2 : 0)) * 512 + 8 * lane);
                  if (pos < 1) x1[u] = (u32x4){0u, 0u, 0u, 0u}; if (pos < 2) x2[u] = (u32x4){0u, 0u, 0u, 0u}; }
#pragma unroll
              for (int u = 0; u < 4; ++u) { const int tok = tok0 + wave * 16 + t4 + u; u32x4 o;
#pragma unroll
                  for (int q = 0; q < 4; ++q) { const float lo = bf_lo(bv[u][q]) * (cw[2][2 * q] * bf_lo(x0[u][q]) + cw[1][2 * q] * bf_lo(x1[u][q]) + cw[0][2 * q] * bf_lo(x2[u][q]));
                      const float hi = bf_hi(bv[u][q]) * (cw[2][2 * q + 1] * bf_hi(x0[u][q]) + cw[1][2 * q + 1] * bf_hi(x1[u][q]) + cw[0][2 * q + 1] * bf_hi(x2[u][q])); o[q] = pk2(lo, hi); }
                  *(u32x4*)(amix + (size_t)tok * 1024 + 512 + 8 * lane) = o; } } }
        __syncthreads();
    }
}

#undef a
__global__ void __launch_bounds__(NWAVES * 64, 2) mega_fwd(Args) {
    extern __shared__ __attribute__((aligned(16))) unsigned char lds_raw[];
    LAS unsigned char* lds = (LAS unsigned char*)lds_raw;
    cg::grid_group grid = cg::this_grid();
    volatile LAS unsigned* bst = (volatile LAS unsigned*)(lds + pg8::LDS_SPARE + 16368);
    if (threadIdx.x < 2) bst[threadIdx.x] = 0u;
    if (blockIdx.x == 0) { unsigned* bw = (unsigned*)kargs()->ws; for (int i = threadIdx.x; i < XCD_BAR_WORDS; i += NWAVES * 64) bw[i] = 0u; }
    prologue(lds);
    grid.sync();
    (void)xcd_barrier_post((unsigned*)kargs()->ws, bst);
#pragma unroll 1
    for (int ph = 0; ph < 14; ++ph) {
        const int L = ph / 7, s = ph % 7;
        const KArgs ap = kargs(); struct { float* out; unsigned char* ws; const float* x; } a; a.out = ap->out; a.ws = ap->ws; a.x = ap->in[I_X];
        if (s == 3) {
#ifndef NO_EVEN
            if (L == 0) even_local(lds);
#endif
#ifndef NO_ODD
            if (L != 0) odd_local(lds);
#endif
        }
        else {
            pg8::Gemm g; pg8::Epi E; E.ws = a.ws; E.lds = lds; E.alpha = 0.f; E.xin = a.out; E.xout = a.out; g.M = M;
            if (s == 0 || s == 5) { g.A = (const bf16*)(a.ws + WS_XB); g.Bt = (const bf16*)(a.ws + WS_WGU) + (size_t)(L * 2 + (s == 5)) * 2 * FF * D; g.N = 2 * FF; g.K = D; E.ptype = 0; }
            else if (s == 1 || s == 6) { g.A = (const bf16*)(a.ws + WS_H); g.Bt = (const bf16*)(a.ws + WS_WDN) + (size_t)(L * 2 + (s == 6)) * D * FF; g.N = D; g.K = FF; E.ptype = 3; E.alpha = 0.5f; if (ph == 1) E.xin = a.x; }
            else if (s == 2) { g.A = (const bf16*)(a.ws + WS_XB); g.Bt = (const bf16*)(a.ws + (L ? WS_WODIN : WS_WEVIN)); g.N = L ? 2560 : 1536; g.K = D; E.ptype = 1 + L; }
            else { g.A = (const bf16*)(a.ws + WS_AMIX); g.Bt = (const bf16*)(a.ws + (L ? WS_WODOUT : WS_WEVOUT)); g.N = D; g.K = D; E.ptype = 3; E.alpha = 1.f; }
            pg8::StaticOrder S; S.init(M, g.N, (int)gridDim.x, (int)blockIdx.x);
            if (E.ptype != 3) {
                LAS float* rst = (LAS float*)(lds + pg8::LDS_SPARE + 4096); const float* part = (const float*)(a.ws + WS_PART);
                f32x4 pv[11];
#pragma unroll
                for (int i = 0; i < 11; ++i) { pg8::Unit uu; pv[i] = (f32x4){0.f, 0.f, 0.f, 0.f}; if (S.next(i, uu) && threadIdx.x < 256) pv[i] = *(const f32x4*)(part + (size_t)(uu.pm * 256 + threadIdx.x) * 4); }
#pragma unroll
                for (int i = 0; i < 11; ++i) { pg8::Unit uu; if (S.next(i, uu) && threadIdx.x < 256) rst[i * 256 + threadIdx.x] = __builtin_amdgcn_rsqf(((pv[i][0] + pv[i][1]) + (pv[i][2] + pv[i][3])) * (1.f / 1024.f) + 1e-6f); }
                __syncthreads();
            }
#ifndef NO_GEMM
            pg8::gemm_phase<pg8::Epi, pg8::StaticOrder, true, true>(lds, g, S, E);
#endif
        }
        { XcdBarrier bar; bar.bar = (unsigned*)kargs()->ws; bar.x = xb_xcc_id(); bar.st = (volatile LAS unsigned*)(lds + pg8::LDS_SPARE + 16368); xcd_barrier(bar); }
    }
    { const KArgs ap = kargs(); struct { float* out; unsigned char* ws; const float* in[26]; } a; a.out = ap->out; a.ws = ap->ws; a.in[I_FINAL] = ap->in[I_FINAL];
      int ftid = threadIdx.x; asm volatile("" : "+v"(ftid));
      const int lane = ftid & 63, gw = blockIdx.x * NWAVES + (ftid >> 6), NGW = gridDim.x * NWAVES; const float* part = (const float*)(a.ws + WS_PART);
      const bf16* xb = (const bf16*)(a.ws + WS_XB);
      f32x4 gn[2][2];
#pragma unroll
      for (int j = 0; j < 2; ++j) { gn[j][0] = *(const f32x4*)(a.in[I_FINAL] + 512 * j + 8 * lane); gn[j][1] = *(const f32x4*)(a.in[I_FINAL] + 512 * j + 8 * lane + 4); }
      for (int m0 = 2 * gw; m0 < M; m0 += 2 * NGW) { u32x4 v[2][2]; float rstd[2];
#pragma unroll
          for (int h = 0; h < 2; ++h) { const f32x4 p = *(const f32x4*)(part + (size_t)(m0 + h) * 4); rstd[h] = __builtin_amdgcn_rsqf(((p[0] + p[1]) + (p[2] + p[3])) * (1.f / 1024.f) + 1e-6f);
#pragma unroll
              for (int j = 0; j < 2; ++j) v[h][j] = *(const u32x4*)(xb + (size_t)(m0 + h) * D + 512 * j + 8 * lane); }
#pragma unroll
          for (int h = 0; h < 2; ++h)
#pragma unroll
              for (int j = 0; j < 2; ++j) { const u32x4 u = v[h][j]; float* o = a.out + (size_t)(m0 + h) * D + 512 * j + 8 * lane;
                  *(f32x4*)o = (f32x4){bf_lo(u.x), bf_hi(u.x), bf_lo(u.y), bf_hi(u.y)} * rstd[h] * gn[j][0];
                  *(f32x4*)(o + 4) = (f32x4){bf_lo(u.z), bf_hi(u.z), bf_lo(u.w), bf_hi(u.w)} * rstd[h] * gn[j][1]; } } }
}

extern "C" void kernel_launch(void* const* d_in, const int* in_sizes, int n_in, void* d_out, int out_size, void* d_ws, size_t ws_size, hipStream_t stream) {
    static int grid = 0;
    if (grid == 0) {
        if (n_in != 26 || in_sizes[0] != M * D || out_size != M * D || ws_size < WS_END) { fprintf(stderr, "kernel_launch: unexpected shapes (n_in %d, ws %zu)\n", n_in, ws_size); grid = -1; return; }
        int dev = 0, cus = 0, per_cu = 0;
        hipGetDevice(&dev); hipDeviceGetAttribute(&cus, hipDeviceAttributeMultiprocessorCount, dev);
        if (hipFuncSetAttribute((const void*)mega_fwd, hipFuncAttributeMaxDynamicSharedMemorySize, LDS_BYTES) != hipSuccess) { fprintf(stderr, "kernel_launch: hipFuncSetAttribute failed\n"); grid = -1; return; }
        if (hipOccupancyMaxActiveBlocksPerMultiprocessor(&per_cu, (const void*)mega_fwd, NWAVES * 64, LDS_BYTES) != hipSuccess || per_cu < 1) { fprintf(stderr, "kernel_launch: occupancy query says %d\n", per_cu); per_cu = 1; }
        (void)hipGetLastError();
        grid = cus * 1;
    }
    if (grid < 0) return;
    Args a{};
    for (int i = 0; i < 26; ++i) a.in[i] = (const float*)d_in[i];
    a.out = (float*)d_out; a.ws = (unsigned char*)d_ws;
    void* kargs[] = {&a};
    hipError_t e = hipLaunchCooperativeKernel((const void*)mega_fwd, dim3(grid), dim3(NWAVES * 64), kargs, LDS_BYTES, stream);
    if (e != hipSuccess) fprintf(stderr, "kernel_launch: cooperative launch failed: %s (grid %d)\n", hipGetErrorString(e), grid);
}
```

```cpp
#include <hip/hip_runtime.h>
#include <hip/hip_cooperative_groups.h>
#include <cstdio>
#include <cstdint>
namespace cg = cooperative_groups;
namespace pg8 {
#define PG8_LAS __attribute__((address_space(3)))
typedef unsigned short bf16_t;
typedef short bf16x8 __attribute__((ext_vector_type(8)));
typedef float f32x4 __attribute__((ext_vector_type(4)));
typedef unsigned u32x4 __attribute__((ext_vector_type(4)));
constexpr int BM = 256, BK = 64, HALF = 128, HTB = HALF * BK * 2  , STAGE_BYTES = 8 * HTB, NXCD = 8, WGM = 8;

__host__ __device__ __forceinline__ int lds_byte(int r, int c) { const int st = (r >> 4) * 2 + (c >> 5), rr = r & 15, cc = c & 31, ob = rr * 64 + cc * 2; return st * 1024 + (ob ^ (((ob >> 9) & 1) << 5)); }
__host__ __device__ __forceinline__ void stage_rc(int b, int& R, int& C) { const int st = b / 1024, sb = b % 1024, swz = sb ^ (((sb >> 9) & 1) << 5); R = (st >> 1) * 16 + swz / 64; C = (st & 1) * 32 + (swz % 64) / 2; }
__host__ __device__ __forceinline__ int perm32(int rho) { const int n = rho >> 4, i = rho & 15; return 8 * (i >> 2) + 4 * n + (i & 3); }

struct Unit { int pm, pn; };
struct Gemm { const bf16_t* A; const bf16_t* Bt; int M, N, K; };

struct StaticOrder {
    int nM, nN, nwg, G, c;
    __host__ __device__ void init(int M, int N, int G_, int c_) { nM = M / BM; nN = N / BM; nwg = nM * nN; G = G_; c = c_; }
    __host__ __device__ bool next(int i, Unit& u) const {
        const long L = (long)i * G + c; if (L >= nwg) return false;
        int wgid = (int)L; { const int q = nwg / NXCD, r = nwg % NXCD, xcd = wgid % NXCD, off = wgid / NXCD; wgid = (xcd < r ? xcd * (q + 1) : r * (q + 1) + (xcd - r) * q) + off; }
        const int nig = WGM * nN, gid = wgid / nig, fm = gid * WGM, gsz = (nM - fm) < WGM ? (nM - fm) : WGM;
        u.pm = fm + ((wgid % nig) % gsz); u.pn = (wgid % nig) / gsz; return true;
    }
    __device__ __forceinline__ void a_ready(const Unit&) const {}
    __device__ __forceinline__ void done(const Unit&) const {}
};
__device__ __forceinline__ unsigned cvt_pk_bf16(float lo, float hi) { unsigned r; asm volatile("v_cvt_pk_bf16_f32 %0, %1, %2" : "=v"(r) : "v"(lo), "v"(hi)); return r; }
typedef float f32x2 __attribute__((ext_vector_type(2)));
constexpr size_t MiB = 1u << 20;
constexpr size_t WS_WGU = 1 * MiB;
constexpr size_t WS_WDN = 45 * MiB;
constexpr size_t WS_WEVIN = 67 * MiB;
constexpr size_t WS_WEVOUT = 70 * MiB;
constexpr size_t WS_WODIN = 72 * MiB;
constexpr size_t WS_WODOUT = 77 * MiB;
constexpr size_t WS_WSGU = 79 * MiB;
constexpr size_t WS_PART = 80 * MiB;
constexpr size_t WS_XB = 82 * MiB;
constexpr size_t WS_H = 146 * MiB;
constexpr size_t WS_Z0 = WS_H, WS_Z1 = WS_H + 32 * MiB, WS_Z2 = WS_H + 64 * MiB, WS_Z3 = WS_H + 96 * MiB;
constexpr size_t WS_AMIX = WS_H + 192 * MiB;
constexpr size_t WS_END = WS_AMIX + 64 * MiB;
constexpr int LDS_BYTES = 147456, LDS_SPARE = 131072;

__device__ __forceinline__ float sigm(float x) { return __builtin_amdgcn_rcpf(1.f + __builtin_amdgcn_exp2f(-1.44269504f * x)); }
__device__ __forceinline__ float gelu_t(float x) { const float u = x * (0.7978845608f + 0.0356774081f * x * x); return x * sigm(2.f * u); }

struct Epi {
    static constexpr bool PERM = true, AFTER_DRAIN = false;
    int ptype;
    unsigned char* ws;
    float alpha; const float* xin; float* xout;
    PG8_LAS unsigned char* lds;
    __device__ __forceinline__ void fused(f32x4 (&)[2][2][4][2], const Unit&, int, int, int, int, PG8_LAS unsigned char*, int, int) const {}
    __device__ __forceinline__ void operator()(const f32x4 (&acc)[2][2][4][2], const Unit& u, int wr, int wc, int fr, int fq, int ui) const {
        const int rowb = u.pm * BM + wr * 64 + fr;
        float* part = (float*)(ws + WS_PART);
        if (ptype == 3) {
            bf16_t* xb = (bf16_t*)(ws + WS_XB);
            const int colb = u.pn * BM + wc * 32 + 8 * fq;
            PG8_LAS float* P = (PG8_LAS float*)(lds + LDS_SPARE);
#pragma unroll
            for (int ai = 0; ai < 2; ++ai)
#pragma unroll
                for (int m = 0; m < 4; ++m) {
                    const size_t off = (size_t)(rowb + ai * HALF + m * 16) * 1024 + colb; float ss = 0.f;
#pragma unroll
                    for (int bj = 0; bj < 2; ++bj) {
                        const u32x4 xo = *(const u32x4*)(xb + off + bj * HALF);
                        const f32x4 x0 = (f32x4){__builtin_bit_cast(float, xo.x << 16), __builtin_bit_cast(float, xo.x & 0xffff0000u), __builtin_bit_cast(float, xo.y << 16), __builtin_bit_cast(float, xo.y & 0xffff0000u)};
                        const f32x4 x1 = (f32x4){__builtin_bit_cast(float, xo.z << 16), __builtin_bit_cast(float, xo.z & 0xffff0000u), __builtin_bit_cast(float, xo.w << 16), __builtin_bit_cast(float, xo.w & 0xffff0000u)};
                        const f32x4 y0 = x0 + alpha * acc[ai][bj][m][0], y1 = x1 + alpha * acc[ai][bj][m][1];
                        u32x4 w; w.x = cvt_pk_bf16(y0[0], y0[1]); w.y = cvt_pk_bf16(y0[2], y0[3]); w.z = cvt_pk_bf16(y1[0], y1[1]); w.w = cvt_pk_bf16(y1[2], y1[3]);
                        *(u32x4*)(xb + off + bj * HALF) = w;
                        ss += (y0[0] * y0[0] + y0[1] * y0[1]) + (y0[2] * y0[2] + y0[3] * y0[3]) + (y1[0] * y1[0] + y1[1] * y1[1]) + (y1[2] * y1[2] + y1[3] * y1[3]);
                    }
                    ss += __shfl_xor(ss, 16); ss += __shfl_xor(ss, 32);
                    if (fq == 0) P[(ai * HALF + wr * 64 + m * 16 + fr) * 4 + wc] = ss;
                }
            asm volatile("s_waitcnt lgkmcnt(0)" ::: "memory"); __builtin_amdgcn_s_barrier(); asm volatile("" ::: "memory");
            if (threadIdx.x < 256) { const f32x4 p = *(const PG8_LAS f32x4*)(P + threadIdx.x * 4); part[(size_t)(u.pm * BM + threadIdx.x) * 4 + u.pn] = (p[0] + p[1]) + (p[2] + p[3]); }
            return;
        }
        float rs[2][4];
        { const PG8_LAS float* rst = (const PG8_LAS float*)(lds + LDS_SPARE + 4096) + ui * 256 + wr * 64 + fr;
#pragma unroll
          for (int ai = 0; ai < 2; ++ai)
#pragma unroll
              for (int m = 0; m < 4; ++m) rs[ai][m] = rst[ai * HALF + m * 16]; }
        int kind, act, ld, col0; size_t obase;
        const int pn = u.pn;
        if (ptype == 0) { kind = 0; act = 0; obase = WS_H; ld = 2816; col0 = 128 * pn; }
        else if (ptype == 1) { ld = 512; if (pn < 4) { kind = 0; act = 1; obase = WS_Z0; col0 = 128 * pn; } else { kind = 1; act = 0; obase = WS_Z1; col0 = 256 * (pn - 4); } }
        else { ld = 512;
            if (pn < 2) { kind = 1; act = 1; obase = WS_Z0; col0 = 256 * pn; } else if (pn < 4) { kind = 1; act = 1; obase = WS_Z1; col0 = 256 * (pn - 2); }
            else if (pn < 6) { kind = 1; act = 0; obase = WS_Z2; col0 = 256 * (pn - 4); } else { kind = 0; act = 2; obase = WS_Z3; col0 = 128 * (pn - 6); } }
        bf16_t* out = (bf16_t*)(ws + obase) + col0 + wc * 32 + 8 * fq;
        if (kind == 0) {
#pragma unroll
            for (int ai = 0; ai < 2; ++ai)
#pragma unroll
                for (int m = 0; m < 4; ++m) { const float r = rs[ai][m]; bf16_t* rowp = out + (size_t)(rowb + ai * HALF + m * 16) * ld;
                    float o[8];
#pragma unroll
                    for (int n = 0; n < 2; ++n)
#pragma unroll
                        for (int i = 0; i < 4; ++i) { const float a = acc[ai][0][m][n][i] * r, b = acc[ai][1][m][n][i] * r;
                            o[n * 4 + i] = (act == 0) ? a * sigm(a) * b : ((act == 1) ? a * sigm(b) : a * b); }
                    u32x4 w; w.x = cvt_pk_bf16(o[0], o[1]); w.y = cvt_pk_bf16(o[2], o[3]); w.z = cvt_pk_bf16(o[4], o[5]); w.w = cvt_pk_bf16(o[6], o[7]);
                    *(u32x4*)rowp = w; }
        } else {
#pragma unroll
            for (int ai = 0; ai < 2; ++ai)
#pragma unroll
                for (int m = 0; m < 4; ++m) { const float r = rs[ai][m]; bf16_t* rowp = out + (size_t)(rowb + ai * HALF + m * 16) * ld;
#pragma unroll
                    for (int bj = 0; bj < 2; ++bj) { float o[8];
#pragma unroll
                        for (int n = 0; n < 2; ++n)
#pragma unroll
                            for (int i = 0; i < 4; ++i) { const float a = acc[ai][bj][m][n][i] * r; o[n * 4 + i] = act ? gelu_t(a) : a; }
                        u32x4 w; w.x = cvt_pk_bf16(o[0], o[1]); w.y = cvt_pk_bf16(o[2], o[3]); w.z = cvt_pk_bf16(o[4], o[5]); w.w = cvt_pk_bf16(o[6], o[7]);
                        *(u32x4*)(rowp + bj * HALF) = w; } }
        }
    }
};

template <class Epi, class Sched, bool ALIGN_EPI = false, bool SP2 = false>
__device__ __forceinline__ void gemm_phase(PG8_LAS unsigned char* lds, const Gemm g, const Sched& S, const Epi& E) {
    const int tid = threadIdx.x, wid = __builtin_amdgcn_readfirstlane(tid >> 6), lane = tid & 63, wr = wid >> 2, wc = wid & 3, fr = lane & 15, fq = lane >> 4;
    const int K = g.K, nt = K / BK;
    const int sr = lane >> 3, sq = (lane & 7) ^ (sr & 6), sR = 8 * wid + sr;
    const int sRb = Epi::PERM ? ((sR & ~31) + perm32(sR & 31)) : sR;
    const unsigned voffA = (unsigned)(sR * K + sq * 8) * 2u, voffB = (unsigned)(sRb * K + sq * 8) * 2u;
    const unsigned h64 = 64u * (unsigned)K * 2u;
    const unsigned kstep = (unsigned)(BK * 2);
    const unsigned hstep = (unsigned)HALF * (unsigned)K * 2u;
    const unsigned tstep = 2u * hstep;
    const unsigned ldsw = (unsigned)wid * 1024u;
    int aoff[2], boff[2];
#pragma unroll
    for (int k = 0; k < 2; ++k) { const int Ra = wr * 64 + fr, Rb_ = wc * 32 + fr, q = 4 * k + fq;
        aoff[k] = (Ra >> 3) * 1024 + ((Ra & 7) * 8 + (q ^ (Ra & 6))) * 16; boff[k] = (Rb_ >> 3) * 1024 + ((Rb_ & 7) * 8 + (q ^ (Rb_ & 6))) * 16; }
#define PG8_SA(b, h) (((b) * 2 + (h)) * HTB)
#define PG8_SB(b, h) ((4 + (b) * 2 + (h)) * HTB)
    const __amdgpu_buffer_rsrc_t rsA = __builtin_amdgcn_make_buffer_rsrc((void*)g.A, (short)0, (int)((unsigned)g.M * (unsigned)K * 2u), 0x00020000);
    const __amdgpu_buffer_rsrc_t rsB = __builtin_amdgcn_make_buffer_rsrc((void*)g.Bt, (short)0, (int)((unsigned)g.N * (unsigned)K * 2u), 0x00020000);
#define PG8_STAGE_R(bufoff, rs, goff, voff) do { _Pragma("unroll") for (int _i = 0; _i < 2; ++_i) \
        __builtin_amdgcn_raw_ptr_buffer_load_lds(rs, (PG8_LAS void*)(lds + (bufoff) + ldsw + _i * 8192), 16, (voff), (goff) + _i * h64, 0, 0); } while (0)
#define PG8_LDA(dst, b, h) do { _Pragma("unroll") for (int m = 0; m < 4; ++m) _Pragma("unroll") for (int k = 0; k < 2; ++k) dst[m][k] = *(const PG8_LAS bf16x8*)(lds + PG8_SA(b, h) + aoff[k] + m * 2048); } while (0)
#define PG8_LDB(dst, b, h) do { _Pragma("unroll") for (int n = 0; n < 2; ++n) _Pragma("unroll") for (int k = 0; k < 2; ++k) dst[n][k] = *(const PG8_LAS bf16x8*)(lds + PG8_SB(b, h) + boff[k] + n * 2048); } while (0)
#define PG8_MMA(ai, bj, At, Bt) do { __builtin_amdgcn_s_setprio(1); _Pragma("unroll") for (int m = 0; m < 4; ++m) _Pragma("unroll") for (int n = 0; n < 2; ++n) _Pragma("unroll") for (int k = 0; k < 2; ++k) \
        acc[ai][bj][m][n] = __builtin_amdgcn_mfma_f32_16x16x32_bf16(Bt[n][k], At[m][k], acc[ai][bj][m][n], 0, 0, 0); __builtin_amdgcn_s_setprio(0); } while (0)
#define PG8_WAIT_V(n) asm volatile("s_waitcnt vmcnt(" #n ")" ::: "memory")
#define PG8_WAIT_L(n) asm volatile("s_waitcnt lgkmcnt(" #n ")" ::: "memory")
#define PG8_BAR __builtin_amdgcn_s_barrier()
#define PG8_SCHED __builtin_amdgcn_sched_barrier(0)
    Unit cur, nxt; int ui = 0;
    if (!S.next(0, cur)) return;
    f32x4 acc[2][2][4][2];
#pragma unroll
    for (int a = 0; a < 2; ++a)
#pragma unroll
        for (int b = 0; b < 2; ++b)
#pragma unroll
            for (int m = 0; m < 4; ++m)
#pragma unroll
                for (int n = 0; n < 2; ++n) acc[a][b][m][n] = (f32x4){0.f, 0.f, 0.f, 0.f};
    bf16x8 At[4][2], B0[2][2], B1[2][2];
    unsigned cA = (unsigned)cur.pm * tstep, cB = (unsigned)cur.pn * tstep;
    S.a_ready(cur);
    if constexpr (SP2) {
        PG8_STAGE_R(PG8_SB(0, 0), rsB, cB, voffB); PG8_STAGE_R(PG8_SB(0, 1), rsB, cB + hstep, voffB); PG8_STAGE_R(PG8_SA(0, 0), rsA, cA, voffA); PG8_STAGE_R(PG8_SA(0, 1), rsA, cA + hstep, voffA);
        if (wr == 1) PG8_BAR;
        PG8_WAIT_V(2); PG8_BAR;
        PG8_STAGE_R(PG8_SB(1, 0), rsB, cB + kstep, voffB); PG8_STAGE_R(PG8_SA(1, 0), rsA, cA + kstep, voffA); PG8_STAGE_R(PG8_SB(1, 1), rsB, cB + hstep + kstep, voffB);
        PG8_WAIT_V(6); PG8_BAR;
    } else {
        PG8_STAGE_R(PG8_SB(0, 0), rsB, cB, voffB); PG8_STAGE_R(PG8_SA(0, 0), rsA, cA, voffA); PG8_STAGE_R(PG8_SB(0, 1), rsB, cB + hstep, voffB); PG8_STAGE_R(PG8_SA(0, 1), rsA, cA + hstep, voffA);
        if (wr == 1) PG8_BAR;
        PG8_WAIT_V(4); PG8_BAR;
        PG8_STAGE_R(PG8_SB(1, 0), rsB, cB + kstep, voffB); PG8_STAGE_R(PG8_SA(1, 0), rsA, cA + kstep, voffA); PG8_STAGE_R(PG8_SB(1, 1), rsB, cB + hstep + kstep, voffB);
        PG8_WAIT_V(6); PG8_BAR;
    }
    for (;;) {
        const bool has_next = S.next(ui + 1, nxt);
        const unsigned nA = has_next ? (unsigned)nxt.pm * tstep : cA, nB = has_next ? (unsigned)nxt.pn * tstep : cB;
        for (int t = 0; t < nt; t += 2) {
            const bool last = (t == nt - 2);
            const unsigned a1 = cA + (unsigned)(t + 1) * kstep;
            const unsigned a2 = last ? nA : cA + (unsigned)(t + 2) * kstep, b2 = last ? nB : cB + (unsigned)(t + 2) * kstep;
            const unsigned a3 = a2 + kstep, b3 = b2 + kstep;
            if (last && has_next) S.a_ready(nxt);
            if constexpr (SP2) {
            PG8_LDB(B0, 0, 0); PG8_LDB(B1, 0, 1); PG8_SCHED; PG8_LDA(At, 0, 0); PG8_STAGE_R(PG8_SA(1, 1), rsA, a1 + hstep, voffA);
            PG8_WAIT_V(8); PG8_WAIT_L(0); PG8_BAR; PG8_MMA(0, 0, At, B0); PG8_MMA(0, 1, At, B1); PG8_BAR; PG8_SCHED;
            PG8_LDA(At, 0, 1); PG8_STAGE_R(PG8_SB(0, 0), rsB, b2, voffB); PG8_STAGE_R(PG8_SB(0, 1), rsB, b2 + hstep, voffB); PG8_STAGE_R(PG8_SA(0, 0), rsA, a2, voffA);
            PG8_WAIT_V(8); PG8_WAIT_L(0); PG8_BAR; PG8_MMA(1, 0, At, B0); PG8_MMA(1, 1, At, B1); PG8_BAR; PG8_SCHED;
            PG8_LDB(B0, 1, 0); PG8_LDB(B1, 1, 1); PG8_SCHED; PG8_LDA(At, 1, 0); PG8_STAGE_R(PG8_SA(0, 1), rsA, a2 + hstep, voffA);
            PG8_WAIT_V(8); PG8_WAIT_L(0); PG8_BAR; PG8_MMA(0, 0, At, B0); PG8_MMA(0, 1, At, B1); PG8_BAR; PG8_SCHED;
            PG8_LDA(At, 1, 1); PG8_STAGE_R(PG8_SB(1, 0), rsB, b3, voffB); PG8_STAGE_R(PG8_SB(1, 1), rsB, b3 + hstep, voffB); PG8_STAGE_R(PG8_SA(1, 0), rsA, a3, voffA);
            PG8_WAIT_V(8); PG8_WAIT_L(0); PG8_BAR; PG8_MMA(1, 0, At, B0); PG8_MMA(1, 1, At, B1); PG8_BAR; PG8_SCHED;
            } else {
            PG8_LDB(B0, 0, 0); PG8_SCHED; PG8_LDA(At, 0, 0); PG8_STAGE_R(PG8_SA(1, 1), rsA, a1 + hstep, voffA);
            PG8_WAIT_L(8); PG8_BAR; PG8_WAIT_L(0); PG8_MMA(0, 0, At, B0); PG8_BAR; PG8_SCHED;
            PG8_LDB(B1, 0, 1); PG8_STAGE_R(PG8_SB(0, 0), rsB, b2, voffB);
            PG8_BAR; PG8_WAIT_L(0); PG8_MMA(0, 1, At, B1); PG8_BAR;
            PG8_LDA(At, 0, 1); PG8_STAGE_R(PG8_SA(0, 0), rsA, a2, voffA);
            PG8_BAR; PG8_WAIT_L(0); PG8_MMA(1, 0, At, B0); PG8_BAR; PG8_SCHED;
            PG8_STAGE_R(PG8_SB(0, 1), rsB, b2 + hstep, voffB);
            PG8_WAIT_V(6); PG8_BAR; PG8_MMA(1, 1, At, B1); PG8_BAR;
            PG8_LDB(B0, 1, 0); PG8_SCHED; PG8_LDA(At, 1, 0); PG8_STAGE_R(PG8_SA(0, 1), rsA, a2 + hstep, voffA);
            PG8_WAIT_L(8); PG8_BAR; PG8_WAIT_L(0); PG8_MMA(0, 0, At, B0); PG8_BAR; PG8_SCHED;
            PG8_LDB(B1, 1, 1); PG8_STAGE_R(PG8_SB(1, 0), rsB, b3, voffB);
            PG8_BAR; PG8_WAIT_L(0); PG8_MMA(0, 1, At, B1); PG8_BAR;
            PG8_LDA(At, 1, 1); PG8_STAGE_R(PG8_SA(1, 0), rsA, a3, voffA);
            PG8_BAR; PG8_WAIT_L(0); PG8_MMA(1, 0, At, B0); PG8_BAR; PG8_SCHED;
            PG8_STAGE_R(PG8_SB(1, 1), rsB, b3 + hstep, voffB);
            PG8_WAIT_V(6); PG8_BAR; PG8_MMA(1, 1, At, B1); PG8_BAR;
            }
        }
        if constexpr (ALIGN_EPI) { if (wr == 0) PG8_BAR; }
        if constexpr (!Epi::AFTER_DRAIN) { E(acc, cur, wr, wc, fr, fq, ui); S.done(cur); }
        if (!has_next) break;
#pragma unroll
        for (int a = 0; a < 2; ++a)
#pragma unroll
            for (int b = 0; b < 2; ++b)
#pragma unroll
                for (int m = 0; m < 4; ++m)
#pragma unroll
                    for (int n = 0; n < 2; ++n) acc[a][b][m][n] = (f32x4){0.f, 0.f, 0.f, 0.f};
        cur = nxt; cA = nA; cB = nB; ++ui;
        if constexpr (ALIGN_EPI) { if (wr == 1) PG8_BAR; }
    }
    PG8_WAIT_V(0);
    if constexpr (!ALIGN_EPI) { if (wr == 0) PG8_BAR; }
    PG8_BAR;
    if constexpr (Epi::AFTER_DRAIN) { E.fused(acc, cur, wr, wc, fr, fq, lds, wid, lane); S.done(cur); }
#undef PG8_SA
#undef PG8_SB
#undef PG8_STAGE_R
#undef PG8_LDA
#undef PG8_LDB
#undef PG8_MMA
#undef PG8_WAIT_V
#undef PG8_WAIT_L
#undef PG8_BAR
#undef PG8_SCHED
}
}
#define LAS __attribute__((address_space(3)))
typedef unsigned short bf16;
typedef float f32x4 __attribute__((ext_vector_type(4)));
typedef float f32x2 __attribute__((ext_vector_type(2)));
typedef unsigned u32x4 __attribute__((ext_vector_type(4)));
typedef unsigned u32x2 __attribute__((ext_vector_type(2)));
typedef short bf16x8 __attribute__((ext_vector_type(8)));
using pg8::WS_WGU; using pg8::WS_WDN; using pg8::WS_WEVIN; using pg8::WS_WEVOUT; using pg8::WS_WODIN; using pg8::WS_WODOUT; using pg8::WS_WSGU; using pg8::WS_PART; using pg8::WS_XB;
using pg8::WS_H; using pg8::WS_Z0; using pg8::WS_Z1; using pg8::WS_Z2; using pg8::WS_Z3; using pg8::WS_AMIX; using pg8::WS_END; using pg8::LDS_BYTES; using pg8::MiB; using pg8::sigm;

constexpr int M = 32768, D = 1024, FF = 2816, SEQ = 2048;
constexpr int NWAVES = 8;
#define LDS_WAIT() asm volatile("s_waitcnt lgkmcnt(0)" ::: "memory")

__device__ __forceinline__ unsigned f2bf(float f) { unsigned u = __builtin_bit_cast(unsigned, f); return (u + 0x7fffu + ((u >> 16) & 1u)) >> 16; }
__device__ __forceinline__ unsigned pk2(float lo, float hi) { return f2bf(lo) | (f2bf(hi) << 16); }
__device__ __forceinline__ float bf_lo(unsigned u) { return __builtin_bit_cast(float, u << 16); }
__device__ __forceinline__ float bf_hi(unsigned u) { return __builtin_bit_cast(float, u & 0xffff0000u); }
__device__ __forceinline__ float wave_sum(float v) {
#pragma unroll
    for (int o = 1; o < 64; o <<= 1) v += __shfl_xor(v, o);
    return v;
}

template <class T> __device__ __forceinline__ T* launder(T* p) { asm volatile("" : "+s"(p)); return p; }
__device__ __forceinline__ int dest_row(int wkind, int n0) {
    if (wkind == 0) return n0;
    if (wkind == 1) return 256 * (n0 >> 7) + (n0 & 127);
    if (wkind == 2) return 256 * (n0 >> 7) + 128 + (n0 & 127);
    if (wkind == 3) { if (n0 < 512) return 256 * (n0 >> 7) + (n0 & 127); if (n0 < 1024) { const int q = n0 - 512; return 256 * (q >> 7) + 128 + (q & 127); } return n0; }
    if (n0 < 1536) return n0;
    if (n0 < 2048) { const int q = n0 - 1536; return 1536 + 256 * (q >> 7) + (q & 127); }
    { const int q = n0 - 2048; return 1536 + 256 * (q >> 7) + 128 + (q & 127); }
}
__device__ __forceinline__ void transpose_item(const float* W, int N, bf16* WT, int kpitch, const float* gain, int wkind, LAS float* scr, int item, int lane) {
    const int nblk = N / 32, kb = item / nblk, nb = item % nblk, k0 = 64 * kb, n0 = 32 * nb;
    float tv[32];
#pragma unroll
    for (int i = 0; i < 32; ++i) tv[i] = W[(size_t)(k0 + 2 * i + (lane >> 5)) * N + n0 + (lane & 31)];
    if (gain) {
#pragma unroll
        for (int i = 0; i < 32; ++i) tv[i] *= gain[k0 + 2 * i + (lane >> 5)]; }
#pragma unroll
    for (int i = 0; i < 32; ++i) scr[(2 * i + (lane >> 5)) * 33 + (lane & 31)] = tv[i];
    LDS_WAIT(); asm volatile("" ::: "memory");
    const int c = lane & 7, drow = dest_row(wkind, n0);
#pragma unroll
    for (int j = 0; j < 4; ++j) { const int n = (lane >> 3) + 8 * j; const LAS float* s = scr + (8 * c) * 33 + n;
        u32x4 o; o.x = pk2(s[0 * 33], s[1 * 33]); o.y = pk2(s[2 * 33], s[3 * 33]); o.z = pk2(s[4 * 33], s[5 * 33]); o.w = pk2(s[6 * 33], s[7 * 33]);
        *(u32x4*)(WT + (size_t)(drow + n) * kpitch + k0 + 8 * c) = o; }
    LDS_WAIT(); asm volatile("" ::: "memory");
}

#define XB_TMO      128
#define XB_XCNT(j)  (256  + 64 * (j))
#define XB_XSUB(j)  (1280 + 64 * (j))
#define XB_XGEN(j)  (2304 + 64 * (j))
#define XB_TOP      3328
#define XB_TOPGEN   3392
#define XCD_BAR_WORDS 3456
#define XB_SPIN_CAP (1u << 18)

__device__ __forceinline__ unsigned xb_ld(unsigned* p)              { return __hip_atomic_load(p, __ATOMIC_RELAXED, __HIP_MEMORY_SCOPE_AGENT); }
__device__ __forceinline__ unsigned xb_add(unsigned* p, unsigned v) { return __hip_atomic_fetch_add(p, v, __ATOMIC_RELAXED, __HIP_MEMORY_SCOPE_AGENT); }
__device__ __forceinline__ unsigned xb_xcc_id() { return (unsigned)__builtin_amdgcn_s_getreg((3 << 11) | 20) & 0xFu; }
#define XB_SPIN(cond, bar) do { unsigned _sp = 0; while (cond) { __builtin_amdgcn_s_sleep(1); \
    if ((++_sp & 255u) == 0u) { if (xb_ld(&(bar)[XB_TMO])) break; if (_sp > XB_SPIN_CAP) { atomicAdd(&(bar)[XB_TMO], 1u); break; } } } } while (0)

struct XcdBarrier {
    unsigned* bar; unsigned x;
    volatile LAS unsigned* st;
};

__device__ __forceinline__ XcdBarrier xcd_barrier_post(unsigned* bar, volatile LAS unsigned* st) {
    XcdBarrier b; b.bar = bar; b.x = xb_xcc_id(); b.st = st;
    if (threadIdx.x == 0) (void)xb_add(&bar[XB_XCNT(b.x)], 1u);
    return b;
}
__device__ __forceinline__ void xcd_barrier_complete(unsigned* bar, unsigned x, unsigned& nloc, unsigned& nx) {
    const unsigned G = gridDim.x * gridDim.y * gridDim.z;
    unsigned sum, cnt, mine, sp = 0u;
    for (;;) {
        sum = 0u; cnt = 0u; mine = 0u;
#pragma unroll
        for (unsigned j = 0; j < 16; ++j) { const unsigned c = xb_ld(&bar[XB_XCNT(j)]); sum += c; cnt += (c > 0u) ? 1u : 0u; mine = (j == x) ? c : mine; }
        if (sum == G) break;
        __builtin_amdgcn_s_sleep(1);
        if ((++sp & 255u) == 0u) { if (xb_ld(&bar[XB_TMO])) break; if (sp > XB_SPIN_CAP) { atomicAdd(&bar[XB_TMO], 1u); break; } }
    }
    nloc = mine > 0u ? mine : 1u; nx = cnt > 0u ? cnt : 1u;
}

__device__ __forceinline__ void xcd_barrier(const XcdBarrier& b) {
    asm volatile("s_waitcnt vmcnt(0)" ::: "memory");
    __syncthreads();
    if (threadIdx.x == 0) {
        unsigned* bar = b.bar;
        __builtin_amdgcn_s_waitcnt(0);
        unsigned nloc = b.st[0], nx = b.st[1];
        if (nloc == 0u) { xcd_barrier_complete(bar, b.x, nloc, nx); b.st[0] = nloc; b.st[1] = nx; }
        const unsigned old = xb_add(&bar[XB_XSUB(b.x)], 1u);
        const unsigned gen = old / nloc;
        if (old + 1u == (gen + 1u) * nloc) {
            __builtin_amdgcn_fence(__ATOMIC_RELEASE, "agent");
            asm volatile("s_waitcnt vmcnt(0)" ::: "memory");
            const unsigned og = xb_add(&bar[XB_TOP], 1u);
            const unsigned tg = og / nx;
            if (og + 1u == (tg + 1u) * nx) xb_add(&bar[XB_TOPGEN], 1u);
            else XB_SPIN(xb_ld(&bar[XB_TOPGEN]) == tg, bar);
            __builtin_amdgcn_fence(__ATOMIC_ACQUIRE, "agent");
            xb_add(&bar[XB_XGEN(b.x)], 1u);
            asm volatile("s_waitcnt vmcnt(0)" ::: "memory");
        } else {
            XB_SPIN(xb_ld(&bar[XB_XGEN(b.x)]) == gen, bar);
            __builtin_amdgcn_fence(__ATOMIC_ACQUIRE, "agent");
            asm volatile("s_waitcnt vmcnt(0)" ::: "memory");
        }
    }
    __syncthreads();
}

struct Args { const float* in[26]; float* out; unsigned char* ws; };
enum { I_X = 0, I_F1N, I_F1G, I_F1U, I_F1D, I_MIXN, I_F2N, I_F2G, I_F2U, I_F2D, I_EVIN, I_EVCW, I_EVCB, I_EVLG, I_EVLB, I_EVPW, I_EVPS, I_EVOUT, I_ODIN, I_ODLG, I_ODLB, I_ODSW, I_ODSB, I_ODCW, I_ODOUT, I_FINAL };

typedef const __attribute__((address_space(4))) Args* KArgs;
__device__ __forceinline__ KArgs kargs() { KArgs p = (KArgs)__builtin_amdgcn_kernarg_segment_ptr(); asm volatile("" : "+s"(p)); return p; }
__device__ __forceinline__ void prologue(LAS unsigned char* lds) {
    const KArgs ap = kargs();
#define a (*ap)
    const int tid = threadIdx.x, lane = tid & 63, wave = tid >> 6;
    LAS float* scr = (LAS float*)(lds + wave * 16384);
    const int gw = blockIdx.x * NWAVES + wave, NGW = gridDim.x * NWAVES;
    unsigned char* ws = a.ws;
    constexpr int I_FFN = (D / 64) * (FF / 32);
    constexpr int N_FFN = 12 * I_FFN, I_EI = 16 * 48, I_OI = 16 * 80, I_EO = 8 * 32, I_OO = 16 * 32, I_FOLD = 4 * 16 * 16;
    constexpr int NITEMS = N_FFN + I_EI + I_OI + I_EO + I_OO + I_FOLD;
    for (int it = gw; it < NITEMS; it += NGW) {
        int r = it;
        if (r < N_FFN) { const int idx = r / I_FFN, item = r % I_FFN, L = idx / 6, q = idx % 6, f = q / 3, kind = q % 3;
            const float* nrm = a.in[f ? I_F2N : I_F1N] + L * D;
            if (kind == 2) transpose_item(a.in[f ? I_F2D : I_F1D] + (size_t)L * FF * D, D, (bf16*)(ws + WS_WDN) + (size_t)(L * 2 + f) * D * FF, FF, nullptr, 0, scr, item, lane);
            else transpose_item(a.in[kind ? (f ? I_F2U : I_F1U) : (f ? I_F2G : I_F1G)] + (size_t)L * D * FF, FF, (bf16*)(ws + WS_WGU) + (size_t)(L * 2 + f) * 2 * FF * D, D, nrm, 1 + kind, scr, item, lane);
            continue; }
        r -= N_FFN;
        if (r < I_EI) { transpose_item(a.in[I_EVIN], 1536, (bf16*)(ws + WS_WEVIN), D, a.in[I_MIXN], 3, scr, r, lane); continue; } r -= I_EI;
        if (r < I_OI) { transpose_item(a.in[I_ODIN], 2560, (bf16*)(ws + WS_WODIN), D, a.in[I_MIXN] + D, 4, scr, r, lane); continue; } r -= I_OI;
        if (r < I_EO) { transpose_item(a.in[I_EVOUT], D, (bf16*)(ws + WS_WEVOUT), D, nullptr, 0, scr, r, lane); continue; } r -= I_EO;
        if (r < I_OO) { transpose_item(a.in[I_ODOUT], D, (bf16*)(ws + WS_WODOUT), D, nullptr, 0, scr, r, lane); continue; } r -= I_OO;
        {
            const int g = r >> 8, c8 = (r >> 4) & 15, n = ((r & 15) << 6) + lane;
            const float* pw = a.in[I_EVPW] + (size_t)(g * 128 + c8 * 8) * 128; const float* ps = a.in[I_EVPS] + g * 128; const float* wo = a.in[I_EVOUT] + (size_t)(512 + g * 128) * D + n;
            float acc[8];
#pragma unroll
            for (int i = 0; i < 8; ++i) acc[i] = 0.f;
#pragma unroll 4
            for (int d = 0; d < 128; ++d) { const float wv = wo[(size_t)d * D] * ps[d];
#pragma unroll
                for (int i = 0; i < 8; ++i) acc[i] += pw[i * 128 + d] * wv; }
            u32x4 o; o.x = pk2(acc[0], acc[1]); o.y = pk2(acc[2], acc[3]); o.z = pk2(acc[4], acc[5]); o.w = pk2(acc[6], acc[7]);
            *(u32x4*)((bf16*)(ws + WS_WEVOUT) + (size_t)n * D + 512 + g * 128 + c8 * 8) = o;
        }
    }
    { const float* x = a.in[I_X]; bf16* xb = (bf16*)(ws + WS_XB); float* part = (float*)(ws + WS_PART);
      for (int m0 = 2 * gw; m0 < M; m0 += 2 * NGW) { f32x4 v[2][4]; float sq[2];
#pragma unroll
          for (int h = 0; h < 2; ++h) { const f32x4* xr = (const f32x4*)(x + (size_t)(m0 + h) * D) + lane;
#pragma unroll
              for (int j = 0; j < 4; ++j) v[h][j] = xr[64 * j]; }
#pragma unroll
          for (int h = 0; h < 2; ++h) { float s = 0.f;
#pragma unroll
              for (int j = 0; j < 4; ++j) s += (v[h][j][0] * v[h][j][0] + v[h][j][1] * v[h][j][1]) + (v[h][j][2] * v[h][j][2] + v[h][j][3] * v[h][j][3]);
              sq[h] = wave_sum(s);
              u32x2* o8 = (u32x2*)(xb + (size_t)(m0 + h) * D) + lane;
#pragma unroll
              for (int j = 0; j < 4; ++j) { u32x2 w; w.x = pk2(v[h][j][0], v[h][j][1]); w.y = pk2(v[h][j][2], v[h][j][3]); o8[64 * j] = w; }
              if (lane == 0) *(f32x4*)(part + (size_t)(m0 + h) * 4) = (f32x4){sq[h], 0.f, 0.f, 0.f}; } } }
    { const float* sw = a.in[I_ODSW]; bf16* wb = (bf16*)(ws + WS_WSGU);
      for (int i = blockIdx.x * 512 + tid; i < 4 * 128 * 128; i += gridDim.x * 512) { const int t = (i >> 7) & 127, s = i & 127; wb[i] = (bf16)(s <= t ? f2bf(sw[i]) : 0u); } }
}

#undef a
__device__ __forceinline__ void even_local(LAS unsigned char* lds) {
    const KArgs ap = kargs();
#define a (*ap)
    int tid_ = threadIdx.x; asm volatile("" : "+v"(tid_));
    const int tid = tid_, lane = tid & 63, wave = tid >> 6, half = tid >> 8, cp = tid & 255;
    constexpr int TT = 32, NR = TT + 30;
    constexpr int R_W = 67584, R_FIN = 133120, SROW = 264;
    LAS unsigned char* tile = lds; LAS float* stt = (LAS float*)lds; LAS float* wl = (LAS float*)(lds + R_W); LAS float* fin = (LAS float*)(lds + R_FIN);
    const bf16* za = (const bf16*)(a.ws + WS_Z0); const bf16* zb = (const bf16*)(a.ws + WS_Z1); unsigned* amix32 = (unsigned*)(a.ws + WS_AMIX);
    for (int i = tid; i < 32 * 512; i += 512) wl[i] = (i < 31 * 512) ? a.in[I_EVCW][i] : 0.f;
    const f32x2 cb = *(const f32x2*)(a.in[I_EVCB] + 2 * cp), lg = *(const f32x2*)(a.in[I_EVLG] + 2 * cp), lb = *(const f32x2*)(a.in[I_EVLB] + 2 * cp);
    const int win = 2 << (wave & 3);
    u32x4 ra[8], rb[6];
    const int sr0 = tid >> 6, sc16 = tid & 63;
#define EV_LOAD_ZA(T0) do { const int _t0 = (T0), _p0 = _t0 & (SEQ - 1); _Pragma("unroll") for (int q = 0; q < 8; ++q) { const int r = sr0 + 8 * q; ra[q] = (u32x4){0u, 0u, 0u, 0u}; \
        if (_p0 - 30 + r >= 0 && r < NR) ra[q] = *(const u32x4*)(za + (size_t)(_t0 - 30 + r) * 512 + sc16 * 8); } } while (0)
#define EV_LOAD_ZB(T0) do { const int _t0 = (T0), _p0 = _t0 & (SEQ - 1); _Pragma("unroll") for (int q = 0; q < 6; ++q) { const int r = sr0 + 8 * q; rb[q] = (u32x4){0u, 0u, 0u, 0u}; \
        if (_p0 - 15 + r >= 0 && r < 47) rb[q] = *(const u32x4*)(zb + (size_t)(_t0 - 15 + r) * 512 + sc16 * 8); } } while (0)
    if ((int)blockIdx.x < M / TT) EV_LOAD_ZA((int)blockIdx.x * TT);
    for (int it = blockIdx.x; it < M / TT; it += gridDim.x) {
        const int t0 = it * TT, pos0 = t0 & (SEQ - 1);
#pragma unroll
        for (int q = 0; q < 8; ++q) { const int r = sr0 + 8 * q; if (r <= NR) *(LAS u32x4*)(tile + r * 1024 + sc16 * 16) = ra[q]; }
        __syncthreads();
        EV_LOAD_ZB(t0);
        if (it + (int)gridDim.x < M / TT) EV_LOAD_ZA((it + (int)gridDim.x) * TT);
        float a0[16], a1[16];
#pragma unroll
        for (int j = 0; j < 16; ++j) { a0[j] = cb.x; a1[j] = cb.y; }
        { const LAS unsigned char* xb = tile + (half * 16) * 1024 + cp * 4;
#pragma unroll 1
          for (int k4 = 0; k4 < 32; k4 += 4) {
              f32x2 w[4]; float x0[19], x1[19];
#pragma unroll
              for (int q = 0; q < 4; ++q) w[q] = *(const LAS f32x2*)(wl + (k4 + q) * 512 + 2 * cp);
#pragma unroll
              for (int i = 0; i < 19; ++i) { const unsigned u = *(const LAS unsigned*)(xb + (k4 + i) * 1024); x0[i] = bf_lo(u); x1[i] = bf_hi(u); }
#pragma unroll
              for (int q = 0; q < 4; ++q)
#pragma unroll
                  for (int j = 0; j < 16; ++j) { a0[j] += w[q].x * x0[j + q]; a1[j] += w[q].y * x1[j + q]; } } }
        __syncthreads();
#pragma unroll
        for (int j = 0; j < 16; ++j) { const int tok = half * 16 + j, col = (cp >> 5) * 33 + (cp & 31);
            stt[tok * SROW + col] = a0[j] + a1[j]; stt[(32 + tok) * SROW + col] = a0[j] * a0[j] + a1[j] * a1[j]; }
        __syncthreads();
        { const int row = tid >> 3, part = tid & 7; const LAS float* p = stt + row * SROW + part * 33; float sacc = 0.f;
#pragma unroll
          for (int i = 0; i < 32; ++i) sacc += p[i];
          sacc += __shfl_xor(sacc, 1); sacc += __shfl_xor(sacc, 2); sacc += __shfl_xor(sacc, 4);
          if (part == 0) fin[row] = sacc; }
        __syncthreads();
#pragma unroll
        for (int q = 0; q < 6; ++q) { const int r = sr0 + 8 * q; if (r < 47) *(LAS u32x4*)(tile + r * 1024 + sc16 * 16) = rb[q]; }
#pragma unroll
        for (int j = 0; j < 16; ++j) { const int tok = half * 16 + j; const float mean = fin[tok] * (1.f / 512.f), var = fmaxf(fin[32 + tok] * (1.f / 512.f) - mean * mean, 0.f), rstd = __builtin_amdgcn_rsqf(var + 1e-6f);
            const float y0 = (a0[j] - mean) * rstd * lg.x + lb.x, y1 = (a1[j] - mean) * rstd * lg.y + lb.y;
            amix32[(size_t)(t0 + tok) * 512 + cp] = pk2(y0 * sigm(y0), y1 * sigm(y1)); }
        __syncthreads();
        { const LAS unsigned char* xb = tile + (15 + half * 16) * 1024 + cp * 4; const int posb = pos0 + half * 16; float s0 = 0.f, s1 = 0.f;
          for (int i = 1; i < win; ++i) { const unsigned u = *(const LAS unsigned*)(xb - i * 1024); s0 += bf_lo(u); s1 += bf_hi(u); }
#pragma unroll
          for (int j = 0; j < 16; ++j) { const unsigned xt = *(const LAS unsigned*)(xb + j * 1024); const float x0 = bf_lo(xt), x1 = bf_hi(xt); s0 += x0; s1 += x1;
              const int pos = posb + j, n = (pos + 1) < win ? (pos + 1) : win; const float rc = 1.f / (float)n;
              amix32[(size_t)(t0 + half * 16 + j) * 512 + 256 + cp] = pk2(s0 * rc - x0, s1 * rc - x1);
              const unsigned uo = *(const LAS unsigned*)(xb + (j - win + 1) * 1024); s0 -= bf_lo(uo); s1 -= bf_hi(uo); } }
        __syncthreads();
    }
}
#undef EV_LOAD_ZA
#undef EV_LOAD_ZB
#undef a
__device__ __forceinline__ void odd_local(LAS unsigned char* lds) {
    const KArgs ap = kargs();
#define a (*ap)
    constexpr int PITCH = 136;
    int tid_ = threadIdx.x; asm volatile("" : "+v"(tid_));
    const int tid = tid_, lane = tid & 63, wave = __builtin_amdgcn_readfirstlane(tid >> 6), fr = lane & 15, fq = lane >> 4;
    LAS bf16* vcT = (LAS bf16*)lds;
    const bf16* cu = (const bf16*)(a.ws + WS_Z0); const bf16* cv = (const bf16*)(a.ws + WS_Z1); const bf16* db = (const bf16*)(a.ws + WS_Z2); const bf16* dcx = (const bf16*)(a.ws + WS_Z3);
    bf16* amix = (bf16*)(a.ws + WS_AMIX); const bf16* wb = (const bf16*)(a.ws + WS_WSGU);
    float lg[8], lb[8];
#pragma unroll
    for (int j = 0; j < 8; ++j) { lg[j] = a.in[I_ODLG][lane + 64 * j]; lb[j] = a.in[I_ODLB][lane + 64 * j]; }
    for (int chunk = blockIdx.x; chunk < M / 128; chunk += gridDim.x) {
        const int tok0 = chunk * 128;
#pragma unroll 1
        for (int t8 = 0; t8 < 16; t8 += 4) { float v[4][8];
#pragma unroll
            for (int u = 0; u < 4; ++u) { const bf16* row = cv + (size_t)(tok0 + wave * 16 + t8 + u) * 512 + lane;
#pragma unroll
                for (int j = 0; j < 8; ++j) v[u][j] = __builtin_bit_cast(float, (unsigned)row[64 * j] << 16); }
            float mean[4], rstd[4];
#pragma unroll
            for (int u = 0; u < 4; ++u) { float s1 = 0.f, s2 = 0.f;
#pragma unroll
                for (int j = 0; j < 8; ++j) { s1 += v[u][j]; s2 += v[u][j] * v[u][j]; }
                s1 = wave_sum(s1); s2 = wave_sum(s2);
                mean[u] = s1 * (1.f / 512.f); rstd[u] = __builtin_amdgcn_rsqf(fmaxf(s2 * (1.f / 512.f) - mean[u] * mean[u], 0.f) + 1e-6f); }
#pragma unroll
            for (int u = 0; u < 4; u += 2) { const int s = wave * 16 + t8 + u;
#pragma unroll
                for (int j = 0; j < 8; ++j) *(LAS unsigned*)(vcT + (lane + 64 * j) * PITCH + s) = pk2((v[u][j] - mean[u]) * rstd[u] * lg[j] + lb[j], (v[u + 1][j] - mean[u + 1]) * rstd[u + 1] * lg[j] + lb[j]); } }
        __syncthreads();
#pragma unroll 1
        for (int g = 0; g < 4; ++g) {
            bf16x8 xa[4];
#pragma unroll
            for (int ks = 0; ks < 4; ++ks) xa[ks] = *(const LAS bf16x8*)(vcT + (g * 128 + 16 * wave + fr) * PITCH + 32 * ks + 8 * fq);
            const int c = g * 128 + 16 * wave + 4 * fq;
            bf16x8 yb[20]; u32x2 cuv[8]; float bs[8];
            { int idx = 0;
#pragma unroll
              for (int tj = 0; tj < 8; ++tj)
#pragma unroll
                  for (int ks = 0; ks <= tj / 2; ++ks) yb[idx++] = *(const bf16x8*)(wb + (size_t)(g * 128 + 16 * tj + fr) * 128 + 32 * ks + 8 * fq); }
#pragma unroll
            for (int tj = 0; tj < 8; ++tj) { const int t = 16 * tj + fr; cuv[tj] = *(const u32x2*)(cu + (size_t)(tok0 + t) * 512 + c); bs[tj] = a.in[I_ODSB][g * 128 + t]; }
            { int idx = 0;
#pragma unroll
              for (int tj = 0; tj < 8; ++tj) { f32x4 d = (f32x4){0.f, 0.f, 0.f, 0.f};
#pragma unroll
                  for (int ks = 0; ks <= tj / 2; ++ks) d = __builtin_amdgcn_mfma_f32_16x16x32_bf16(xa[ks], yb[idx++], d, 0, 0, 0);
                  const float bias = bs[tj]; const u32x2 uu = cuv[tj];
                  u32x2 o; o.x = pk2(bf_lo(uu.x) * (d[0] + bias), bf_hi(uu.x) * (d[1] + bias)); o.y = pk2(bf_lo(uu.y) * (d[2] + bias), bf_hi(uu.y) * (d[3] + bias));
                  *(u32x2*)(amix + (size_t)(tok0 + 16 * tj + fr) * 1024 + c) = o; } }
        }
        { float cw[3][8];
#pragma unroll
          for (int k = 0; k < 3; ++k) { const f32x4 p = *(const f32x4*)(a.in[I_ODCW] + k * 512 + 8 * lane), q = *(const f32x4*)(a.in[I_ODCW] + k * 512 + 8 * lane + 4);
              cw[k][0] = p[0]; cw[k][1] = p[1]; cw[k][2] = p[2]; cw[k][3] = p[3]; cw[k][4] = q[0]; cw[k][5] = q[1]; cw[k][6] = q[2]; cw[k][7] = q[3]; }
#pragma unroll 1
          for (int t4 = 0; t4 < 16; t4 += 4) { u32x4 bv[4], x0[4], x1[4], x2[4];
#pragma unroll
              for (int u = 0; u < 4; ++u) { const int tok = tok0 + wave * 16 + t4 + u, pos = tok & (SEQ - 1);
                  bv[u] = *(const u32x4*)(db + (size_t)tok * 512 + 8 * lane); x0[u] = *(const u32x4*)(dcx + (size_t)tok * 512 + 8 * lane);
                  x1[u] = *(const u32x4*)(dcx + (size_t)(tok - (pos >= 1 ? 1 : 0)) * 512 + 8 * lane); x2[u] = *(const u32x4*)(dcx + (size_t)(tok - (pos >= 2 ? 2 : 0)) * 512 + 8 * lane);
                  if (pos < 1) x1[u] = (u32x4){0u, 0u, 0u, 0u}; if (pos < 2) x2[u] = (u32x4){0u, 0u, 0u, 0u}; }
#pragma unroll
              for (int u = 0; u < 4; ++u) { const int tok = tok0 + wave * 16 + t4 + u; u32x4 o;
#pragma unroll
                  for (int q = 0; q < 4; ++q) { const float lo = bf_lo(bv[u][q]) * (cw[2][2 * q] * bf_lo(x0[u][q]) + cw[1][2 * q] * bf_lo(x1[u][q]) + cw[0][2 * q] * bf_lo(x2[u][q]));
                      const float hi = bf_hi(bv[u][q]) * (cw[2][2 * q + 1] * bf_hi(x0[u][q]) + cw[1][2 * q + 1] * bf_hi(x1[u][q]) + cw[0][2 * q + 1] * bf_hi(x2[u][q])); o[q] = pk2(lo, hi); }
                  *(u32x4*)(amix + (size_t)tok * 1024 + 512 + 8 * lane) = o; } } }
        __syncthreads();
    }
}

#undef a
__global__ void __launch_bounds__(NWAVES * 64, 2) mega_fwd(Args) {
    extern __shared__ __attribute__((aligned(16))) unsigned char lds_raw[];
    LAS unsigned char* lds = (LAS unsigned char*)lds_raw;
    cg::grid_group grid = cg::this_grid();
    volatile LAS unsigned* bst = (volatile LAS unsigned*)(lds + pg8::LDS_SPARE + 16368);
    if (threadIdx.x < 2) bst[threadIdx.x] = 0u;
    if (blockIdx.x == 0) { unsigned* bw = (unsigned*)kargs()->ws; for (int i = threadIdx.x; i < XCD_BAR_WORDS; i += NWAVES * 64) bw[i] = 0u; }
    prologue(lds);
    grid.sync();
    (void)xcd_barrier_post((unsigned*)kargs()->ws, bst);
#pragma unroll 1
    for (int ph = 0; ph < 14; ++ph) {
        const int L = ph / 7, s = ph % 7;
        const KArgs ap = kargs(); struct { float* out; unsigned char* ws; const float* x; } a; a.out = ap->out; a.ws = ap->ws; a.x = ap->in[I_X];
        if (s == 3) {
#ifndef NO_EVEN
            if (L == 0) even_local(lds);
#endif
#ifndef NO_ODD
            if (L != 0) odd_local(lds);
#endif
        }
        else {
            pg8::Gemm g; pg8::Epi E; E.ws = a.ws; E.lds = lds; E.alpha = 0.f; E.xin = a.out; E.xout = a.out; g.M = M;
            if (s == 0 || s == 5) { g.A = (const bf16*)(a.ws + WS_XB); g.Bt = (const bf16*)(a.ws + WS_WGU) + (size_t)(L * 2 + (s == 5)) * 2 * FF * D; g.N = 2 * FF; g.K = D; E.ptype = 0; }
            else if (s == 1 || s == 6) { g.A = (const bf16*)(a.ws + WS_H); g.Bt = (const bf16*)(a.ws + WS_WDN) + (size_t)(L * 2 + (s == 6)) * D * FF; g.N = D; g.K = FF; E.ptype = 3; E.alpha = 0.5f; if (ph == 1) E.xin = a.x; }
            else if (s == 2) { g.A = (const bf16*)(a.ws + WS_XB); g.Bt = (const bf16*)(a.ws + (L ? WS_WODIN : WS_WEVIN)); g.N = L ? 2560 : 1536; g.K = D; E.ptype = 1 + L; }
            else { g.A = (const bf16*)(a.ws + WS_AMIX); g.Bt = (const bf16*)(a.ws + (L ? WS_WODOUT : WS_WEVOUT)); g.N = D; g.K = D; E.ptype = 3; E.alpha = 1.f; }
            pg8::StaticOrder S; S.init(M, g.N, (int)gridDim.x, (int)blockIdx.x);
            if (E.ptype != 3) {
                LAS float* rst = (LAS float*)(lds + pg8::LDS_SPARE + 4096); const float* part = (const float*)(a.ws + WS_PART);
                const int nun = (128 * (g.N / 256)) / 256, cq = (int)blockIdx.x >> 3, nn8 = 8 * (g.N / 256), pbase = 16 * ((int)blockIdx.x & 7) + (cq & 7);
                f32x4 pv[11];
#pragma unroll
                for (int i = 0; i < 11; ++i) { pv[i] = (f32x4){0.f, 0.f, 0.f, 0.f};
                    if (i < nun && threadIdx.x < 256) pv[i] = *(const f32x4*)(part + (size_t)((pbase + 8 * ((32 * i + cq) / nn8)) * 256 + threadIdx.x) * 4); }
#pragma unroll
                for (int i = 0; i < 11; ++i) if (i < nun && threadIdx.x < 256) rst[i * 256 + threadIdx.x] = __builtin_amdgcn_rsqf(((pv[i][0] + pv[i][1]) + (pv[i][2] + pv[i][3])) * (1.f / 1024.f) + 1e-6f);
                __syncthreads();
            }
#ifndef NO_GEMM
            pg8::gemm_phase<pg8::Epi, pg8::StaticOrder, true, true>(lds, g, S, E);
#endif
        }
        { XcdBarrier bar; bar.bar = (unsigned*)kargs()->ws; bar.x = xb_xcc_id(); bar.st = (volatile LAS unsigned*)(lds + pg8::LDS_SPARE + 16368); xcd_barrier(bar); }
    }
    { const KArgs ap = kargs(); struct { float* out; unsigned char* ws; const float* in[26]; } a; a.out = ap->out; a.ws = ap->ws; a.in[I_FINAL] = ap->in[I_FINAL];
      const int lane = threadIdx.x & 63, gw = blockIdx.x * NWAVES + (threadIdx.x >> 6), NGW = gridDim.x * NWAVES; const float* part = (const float*)(a.ws + WS_PART);
      const bf16* xb = (const bf16*)(a.ws + WS_XB);
      f32x4 gn[2][2];
#pragma unroll
      for (int j = 0; j < 2; ++j) { gn[j][0] = *(const f32x4*)(a.in[I_FINAL] + 512 * j + 8 * lane); gn[j][1] = *(const f32x4*)(a.in[I_FINAL] + 512 * j + 8 * lane + 4); }
      for (int m0 = 2 * gw; m0 < M; m0 += 2 * NGW) { u32x4 v[2][2]; float rstd[2];
#pragma unroll
          for (int h = 0; h < 2; ++h) { const f32x4 p = *(const f32x4*)(part + (size_t)(m0 + h) * 4); rstd[h] = __builtin_amdgcn_rsqf(((p[0] + p[1]) + (p[2] + p[3])) * (1.f / 1024.f) + 1e-6f);
#pragma unroll
              for (int j = 0; j < 2; ++j) v[h][j] = *(const u32x4*)(xb + (size_t)(m0 + h) * D + 512 * j + 8 * lane); }
#pragma unroll
          for (int h = 0; h < 2; ++h)
#pragma unroll
              for (int j = 0; j < 2; ++j) { const u32x4 u = v[h][j]; float* o = a.out + (size_t)(m0 + h) * D + 512 * j + 8 * lane;
                  *(f32x4*)o = (f32x4){bf_lo(u.x), bf_hi(u.x), bf_lo(u.y), bf_hi(u.y)} * rstd[h] * gn[j][0];
                  *(f32x4*)(o + 4) = (f32x4){bf_lo(u.z), bf_hi(u.z), bf_lo(u.w), bf_hi(u.w)} * rstd[h] * gn[j][1]; } } }
}

extern "C" void kernel_launch(void* const* d_in, const int* in_sizes, int n_in, void* d_out, int out_size, void* d_ws, size_t ws_size, hipStream_t stream) {
    static int grid = 0;
    if (grid == 0) {
        if (n_in != 26 || in_sizes[0] != M * D || out_size != M * D || ws_size < WS_END) { fprintf(stderr, "kernel_launch: unexpected shapes (n_in %d, ws %zu)\n", n_in, ws_size); grid = -1; return; }
        int dev = 0, cus = 0, per_cu = 0;
        hipGetDevice(&dev); hipDeviceGetAttribute(&cus, hipDeviceAttributeMultiprocessorCount, dev);
        if (hipFuncSetAttribute((const void*)mega_fwd, hipFuncAttributeMaxDynamicSharedMemorySize, LDS_BYTES) != hipSuccess) { fprintf(stderr, "kernel_launch: hipFuncSetAttribute failed\n"); grid = -1; return; }
        if (hipOccupancyMaxActiveBlocksPerMultiprocessor(&per_cu, (const void*)mega_fwd, NWAVES * 64, LDS_BYTES) != hipSuccess || per_cu < 1) { fprintf(stderr, "kernel_launch: occupancy query says %d\n", per_cu); per_cu = 1; }
        (void)hipGetLastError();
        grid = cus * 1;
    }
    if (grid < 0) return;
    Args a{};
    for (int i = 0; i < 26; ++i) a.in[i] = (const float*)d_in[i];
    a.out = (float*)d_out; a.ws = (unsigned char*)d_ws;
    void* kargs[] = {&a};
    hipError_t e = hipLaunchCooperativeKernel((const void*)mega_fwd, dim3(grid), dim3(NWAVES * 64), kargs, LDS_BYTES, stream);
    if (e != hipSuccess) fprintf(stderr, "kernel_launch: cooperative launch failed: %s (grid %d)\n", hipGetErrorString(e), grid);
}
```
